# Optimizing an MI355X kernel written in HIP

```python
import jax
import jax.numpy as jnp
from jax import lax
import numpy as np

D_MODEL = 1024
BATCH = 16
SEQ = 2048
DEPTH = 2

CHUNK = 64
PLE_DIM = 256
HEAD_DIM = 64
D_RWKV = D_MODEL // 2
H_RWKV = D_RWKV // HEAD_DIM
D_ATT = D_MODEL - D_RWKV
H_ATT = D_ATT // HEAD_DIM
LORA_DECAY = 64
LORA_ICLR = 64
LORA_GATE = 128
LORA_VRES = 32
N_RWKV_IN = 3 * D_RWKV + LORA_DECAY + LORA_ICLR + LORA_GATE
N_ATT_IN = 3 * D_ATT
N_IN = N_RWKV_IN + N_ATT_IN
RWKV_SPLITS = (D_RWKV, 2 * D_RWKV, 3 * D_RWKV, 3 * D_RWKV + LORA_DECAY, 3 * D_RWKV + LORA_DECAY + LORA_ICLR)
LEFT_CHUNKS = 8
BAND = (LEFT_CHUNKS + 1) * CHUNK
MAX_REL = 256
N_REL = CHUNK + MAX_REL
N_GROUPS = 4
EXPERTS_PER_GROUP = 8
TOP_K = 2
D_EXPERT = 256
RMS_EPS = 1e-6
GN_EPS = 64e-5
NEG_INF = -1e30

kernel_name = 'hybrid_rwkv7_chunkattn_hmoe_ple'


def rms_norm(x, w):
    xf = x.astype(jnp.float32)
    y = xf * lax.rsqrt(jnp.mean(xf * xf, axis=-1, keepdims=True) + RMS_EPS)
    return (y * w.astype(jnp.float32)).astype(x.dtype)


def token_shift_mix(z, mu):
    z_prev = jnp.pad(z, ((0, 0), (1, 0), (0, 0)))[:, :-1]
    return z + (z_prev - z) * mu


def rwkv7_recurrence(r, decay, k, v, a, b):
    bsz, _, nh, n = r.shape

    def step(state, inp):
        r_t, w_t, k_t, v_t, a_t, b_t = inp
        sa = jnp.einsum('bhij,bhj->bhi', state, a_t)
        state = (state * w_t[:, :, None, :] + sa[..., None] * b_t[:, :, None, :]
                 + v_t[..., None] * k_t[:, :, None, :])
        y_t = jnp.einsum('bhij,bhj->bhi', state, r_t)
        return state, y_t

    s0 = jnp.zeros((bsz, nh, n, n), jnp.float32)
    xs = tuple(jnp.moveaxis(t, 1, 0) for t in (r, decay, k, v, a, b))
    _, ys = lax.scan(step, s0, xs)
    return jnp.moveaxis(ys, 0, 1)


def rwkv7_time_mix(z, v_first, v_res, w0, w2, a0, a2, g2, k_k, k_a, r_k, ln_w, ln_b):
    out_dtype = z.dtype
    z = z.astype(jnp.float32)
    bsz, seq, _ = z.shape
    r, k, v, w_lo, a_lo, g_lo = jnp.split(z, RWKV_SPLITS, axis=-1)
    if v_res is None:
        v_first = v
    else:
        v0, v1, v2 = v_res
        v = v + (v_first - v) * jax.nn.sigmoid(v0 + (v @ v1) @ v2)
    w_log = -jax.nn.softplus(-(w0 + jnp.tanh(w_lo) @ w2)) - 0.5
    decay = jnp.exp(-jnp.exp(w_log))
    a = jax.nn.sigmoid(a0 + a_lo @ a2)
    g = jax.nn.sigmoid(g_lo) @ g2

    def heads(t):
        return t.reshape(bsz, seq, H_RWKV, HEAD_DIM)

    kk = heads(k * k_k)
    kk = kk * lax.rsqrt(jnp.maximum(jnp.sum(kk * kk, axis=-1, keepdims=True), 1e-24))
    k = k * (1.0 + (a - 1.0) * k_a)
    rh, kh, vh, ah = heads(r), heads(k), heads(v), heads(a)
    y = rwkv7_recurrence(rh, heads(decay), kh, vh, -kk, kk * ah)
    mean = jnp.mean(y, axis=-1, keepdims=True)
    var = jnp.mean(jnp.square(y - mean), axis=-1, keepdims=True)
    y = ((y - mean) * lax.rsqrt(var + GN_EPS)).reshape(bsz, seq, D_RWKV) * ln_w + ln_b
    bonus = jnp.sum(rh * kh * r_k.reshape(H_RWKV, HEAD_DIM), axis=-1, keepdims=True) * vh
    y = y + bonus.reshape(bsz, seq, D_RWKV)
    return (y * g).astype(out_dtype), v_first


def chunk_band_attention(q, k, v, rel_bias):
    bsz, seq, nh, dh = q.shape
    nc = seq // CHUNK
    pad = ((0, 0), (LEFT_CHUNKS * CHUNK, 0), (0, 0), (0, 0))
    k_pad = jnp.pad(k, pad)
    v_pad = jnp.pad(v, pad)
    qi = jnp.arange(CHUNK)[:, None]
    kj = jnp.arange(BAND)
    rel = qi + LEFT_CHUNKS * CHUNK - kj[None, :]
    rel_idx = jnp.clip(rel, -(CHUNK - 1), MAX_REL) + (CHUNK - 1)
    bias = rel_bias[:, rel_idx].astype(jnp.float32)
    q_chunks = jnp.moveaxis(q.reshape(bsz, nc, CHUNK, nh, dh), 1, 0)
    scale = dh ** -0.5

    def one_chunk(args):
        c, qc = args
        kb = lax.dynamic_slice_in_dim(k_pad, c * CHUNK, BAND, axis=1)
        vb = lax.dynamic_slice_in_dim(v_pad, c * CHUNK, BAND, axis=1)
        s = jnp.einsum('bqhd,bkhd->bhqk', qc, kb).astype(jnp.float32) * scale + bias
        valid = kj >= (LEFT_CHUNKS - c) * CHUNK
        s = jnp.where(valid, s, NEG_INF)
        pr = jax.nn.softmax(s, axis=-1).astype(vb.dtype)
        return jnp.einsum('bhqk,bkhd->bqhd', pr, vb)

    out = lax.map(one_chunk, (jnp.arange(nc), q_chunks))
    return jnp.moveaxis(out, 0, 1).reshape(bsz, seq, nh * dh)


def hierarchical_moe(x, wg, bg, we, be, w1, w3, w2):
    bsz, seq, d = x.shape
    t = x.reshape(-1, d)
    group_prob = jax.nn.softmax((t @ wg + bg).astype(jnp.float32), axis=-1)
    g_sel = jnp.argmax(group_prob, axis=-1)
    p_g = jnp.take_along_axis(group_prob, g_sel[:, None], axis=-1)
    exp_logits = (t @ we + be).astype(jnp.float32).reshape(-1, N_GROUPS, EXPERTS_PER_GROUP)
    sel_logits = jnp.take_along_axis(exp_logits, g_sel[:, None, None], axis=1)[:, 0]
    exp_prob = jax.nn.softmax(sel_logits, axis=-1)
    top_v, top_i = lax.top_k(exp_prob, TOP_K)
    top_v = top_v / jnp.sum(top_v, axis=-1, keepdims=True)
    w_group = jnp.sum(jax.nn.one_hot(top_i, EXPERTS_PER_GROUP, dtype=jnp.float32) * top_v[..., None], axis=1)
    combine = (jax.nn.one_hot(g_sel, N_GROUPS, dtype=jnp.float32)[:, :, None]
               * (p_g * w_group)[:, None, :]).astype(x.dtype)
    out = jnp.zeros_like(t)
    for gi in range(N_GROUPS):
        h_gate = jnp.einsum('td,edf->tef', t, w1[gi])
        h_up = jnp.einsum('td,edf->tef', t, w3[gi])
        hid = jax.nn.silu(h_gate) * h_up * combine[:, gi, :, None]
        out = out + jnp.einsum('tef,efd->td', hid, w2[gi])
    return out.reshape(bsz, seq, d)


def setup_inputs(seed: int = 0) -> dict:
    key = jax.random.key(seed)
    ks = list(jax.random.split(key, 40))
    cnt = [0]
    f32 = jnp.float32

    def nk():
        cnt[0] += 1
        return ks[cnt[0] - 1]

    def nrm(shape, scale):
        return jax.random.normal(nk(), shape, f32) * scale

    def unif(shape, lo, hi):
        return jax.random.uniform(nk(), shape, f32, lo, hi)

    L = DEPTH
    Lv = DEPTH - 1
    return {
        'x': nrm((BATCH, SEQ, D_MODEL), 1.0),
        'p': nrm((DEPTH, BATCH, SEQ, PLE_DIM), 1.0),
        'norm_mix_w': 1.0 + nrm((L, D_MODEL), 0.02),
        'w_in': nrm((L, D_MODEL, N_IN), D_MODEL ** -0.5),
        'rwkv_mu': unif((L, N_RWKV_IN), 0.0, 1.0),
        'rwkv_w0': unif((L, D_RWKV), -6.0, -1.0),
        'rwkv_w2': nrm((L, LORA_DECAY, D_RWKV), 0.5 * LORA_DECAY ** -0.5),
        'rwkv_a0': nrm((L, D_RWKV), 0.1),
        'rwkv_a2': nrm((L, LORA_ICLR, D_RWKV), 0.5 * LORA_ICLR ** -0.5),
        'rwkv_g2': nrm((L, LORA_GATE, D_RWKV), LORA_GATE ** -0.5),
        'rwkv_k_k': 0.85 + nrm((L, D_RWKV), 0.02),
        'rwkv_k_a': 1.0 + nrm((L, D_RWKV), 0.02),
        'rwkv_r_k': nrm((L, D_RWKV), 0.1),
        'rwkv_ln_w': 1.0 + nrm((L, D_RWKV), 0.02),
        'rwkv_ln_b': nrm((L, D_RWKV), 0.01),
        'rwkv_v0': 1.0 + nrm((Lv, D_RWKV), 0.1),
        'rwkv_v1': nrm((Lv, D_RWKV, LORA_VRES), D_RWKV ** -0.5),
        'rwkv_v2': nrm((Lv, LORA_VRES, D_RWKV), 0.5 * LORA_VRES ** -0.5),
        'att_rel_bias': nrm((L, H_ATT, N_REL), 0.1),
        'w_out': nrm((L, D_MODEL, D_MODEL), D_MODEL ** -0.5),
        'norm_ffn_w': 1.0 + nrm((L, D_MODEL), 0.02),
        'router_group_w': nrm((L, D_MODEL, N_GROUPS), D_MODEL ** -0.5),
        'router_group_b': nrm((L, N_GROUPS), 0.01),
        'router_expert_w': nrm((L, D_MODEL, N_GROUPS * EXPERTS_PER_GROUP), D_MODEL ** -0.5),
        'router_expert_b': nrm((L, N_GROUPS * EXPERTS_PER_GROUP), 0.01),
        'expert_w1': nrm((L, N_GROUPS, EXPERTS_PER_GROUP, D_MODEL, D_EXPERT), D_MODEL ** -0.5),
        'expert_w3': nrm((L, N_GROUPS, EXPERTS_PER_GROUP, D_MODEL, D_EXPERT), D_MODEL ** -0.5),
        'expert_w2': nrm((L, N_GROUPS, EXPERTS_PER_GROUP, D_EXPERT, D_MODEL), D_EXPERT ** -0.5),
        'norm_ple_w': 1.0 + nrm((L, D_MODEL), 0.02),
        'ple_gate_w': nrm((L, D_MODEL, D_MODEL), D_MODEL ** -0.5),
        'ple_gate_b': nrm((L, D_MODEL), 0.01),
        'ple_proj_w': nrm((L, PLE_DIM, D_MODEL), PLE_DIM ** -0.5),
        'final_norm_w': 1.0 + nrm((D_MODEL,), 0.02),
    }


def reference(x, p, norm_mix_w, w_in, rwkv_mu, rwkv_w0, rwkv_w2, rwkv_a0, rwkv_a2, rwkv_g2,
              rwkv_k_k, rwkv_k_a, rwkv_r_k, rwkv_ln_w, rwkv_ln_b, rwkv_v0, rwkv_v1, rwkv_v2,
              att_rel_bias, w_out, norm_ffn_w, router_group_w, router_group_b,
              router_expert_w, router_expert_b, expert_w1, expert_w3, expert_w2,
              norm_ple_w, ple_gate_w, ple_gate_b, ple_proj_w, final_norm_w):
    h = x
    bsz, seq, _ = x.shape
    v_first = None
    for i in range(DEPTH):
        hn = rms_norm(h, norm_mix_w[i])
        z = hn @ w_in[i]
        z_rwkv = token_shift_mix(z[..., :N_RWKV_IN], rwkv_mu[i])
        z_att = z[..., N_RWKV_IN:]
        v_res = None if i == 0 else (rwkv_v0[i - 1], rwkv_v1[i - 1], rwkv_v2[i - 1])
        y_rwkv, v_first = rwkv7_time_mix(z_rwkv, v_first, v_res, rwkv_w0[i], rwkv_w2[i],
                                         rwkv_a0[i], rwkv_a2[i], rwkv_g2[i], rwkv_k_k[i],
                                         rwkv_k_a[i], rwkv_r_k[i], rwkv_ln_w[i], rwkv_ln_b[i])
        q, k, v = jnp.split(z_att, 3, axis=-1)
        q = q.reshape(bsz, seq, H_ATT, HEAD_DIM)
        k = k.reshape(bsz, seq, H_ATT, HEAD_DIM)
        v = v.reshape(bsz, seq, H_ATT, HEAD_DIM)
        y_att = chunk_band_attention(q, k, v, att_rel_bias[i])
        h = h + jnp.concatenate([y_rwkv, y_att.astype(y_rwkv.dtype)], axis=-1) @ w_out[i]
        h = h + hierarchical_moe(rms_norm(h, norm_ffn_w[i]), router_group_w[i], router_group_b[i],
                                 router_expert_w[i], router_expert_b[i],
                                 expert_w1[i], expert_w3[i], expert_w2[i])
        gate = jax.nn.sigmoid(rms_norm(h, norm_ple_w[i]) @ ple_gate_w[i] + ple_gate_b[i])
        h = h + gate * (p[i] @ ple_proj_w[i])
    return rms_norm(h, final_norm_w)
```

```cpp
#include <hip/hip_runtime.h>
#include <cstdio>
#include <cstdint>

#ifndef LOCAL_REP
#define LOCAL_REP 0
#endif
#ifndef MK_ONE_LAUNCH
#define MK_ONE_LAUNCH 1
#endif

#define LAS __attribute__((address_space(3)))
#define GAS __attribute__((address_space(1)))
typedef unsigned short bf16;
typedef short bf16x8 __attribute__((ext_vector_type(8)));
typedef short s16x4 __attribute__((ext_vector_type(4)));
typedef float f32x4 __attribute__((ext_vector_type(4)));
typedef float f32x2 __attribute__((ext_vector_type(2)));
typedef float f32x16 __attribute__((ext_vector_type(16)));
typedef unsigned u32x4 __attribute__((ext_vector_type(4)));
typedef unsigned u32x2 __attribute__((ext_vector_type(2)));

constexpr int T = 32768, D = 1024, SEQ = 2048, NBATCH = 16;
constexpr int NIN = 3328, NR = 1792, NA = 1536, NEXP = 32;
constexpr int HIDROWS = 2 * T + NEXP * 256;
constexpr float RMS_EPS = 1e-6f, GN_EPS = 64e-5f;

constexpr size_t MiB = 1u << 20;
constexpr size_t WS_CTL = 0, CTL_ZERO_BYTES = 1 * MiB;
constexpr size_t WS_TAB = 1 * MiB;
constexpr size_t TAB_WRH = 0, TAB_WRL = 96 * 1024, TAB_W2T = 256 * 1024, TAB_A2T = 320 * 1024, TAB_G2T = 384 * 1024, TAB_V2T = 512 * 1024, TAB_V1T = 544 * 1024;
constexpr size_t WS_W = 4 * MiB;
constexpr size_t W_IN = 0, W_OUT = 6656 * 1024, W_13 = 8704 * 1024, W_2 = (8704 + 32768) * 1024, W_PG = (8704 + 49152) * 1024, W_PP = (8704 + 49152 + 2048) * 1024;
constexpr size_t WS_XB = 64 * MiB;
constexpr size_t WS_PR = 64 * MiB, WS_PK = 96 * MiB;
constexpr size_t WS_ZR = 128 * MiB;
constexpr size_t WS_YC = 128 * MiB, WS_HID = 128 * MiB;
constexpr size_t WS_Y2 = 192 * MiB;
constexpr size_t WS_ZA = 240 * MiB;
constexpr size_t WS_PV = 336 * MiB, WS_PA = 368 * MiB, WS_PG = 400 * MiB, WS_PL = 432 * MiB;
constexpr size_t WS_PP = 336 * MiB;
constexpr size_t WS_PB = 400 * MiB;
constexpr size_t WS_VF = 464 * MiB;
constexpr size_t WS_PERM = 496 * MiB, WS_SRS = 500 * MiB, WS_SCW = 504 * MiB, WS_TOKSLOT = 508 * MiB, WS_RSTD = 509 * MiB;
constexpr size_t WS_WE = 510 * MiB, WS_BS = 511 * MiB;
constexpr size_t WS_END = 512 * MiB;
constexpr int CW_BAR = 4096, CW_QUEUE = 8192, CW_CNT = 16384;

constexpr int RING_BYTES = 131072, LDSCTL_OFF = 160768, LDS_BYTES = 163840;
constexpr int LC_XB = 0, LC_PREFIX = 64, LC_EBASE = 256, LC_CNT = 512, LC_Q = 768, LC_ROT = 1024;

__device__ __forceinline__ unsigned f2bf(float f) { unsigned u = __builtin_bit_cast(unsigned, f); return (u + 0x7fffu + ((u >> 16) & 1u)) >> 16; }
typedef __bf16 bf16x2_t __attribute__((ext_vector_type(2)));
__device__ __forceinline__ unsigned pk2(float lo, float hi) { const f32x2 v = {lo, hi}; const bf16x2_t b = __builtin_convertvector(v, bf16x2_t); return __builtin_bit_cast(unsigned, b); }
__device__ __forceinline__ float bf_lo(unsigned w) { return __builtin_bit_cast(float, w << 16); }
__device__ __forceinline__ float bf_hi(unsigned w) { return __builtin_bit_cast(float, w & 0xffff0000u); }
__device__ __forceinline__ float bf2f(bf16 b) { return __builtin_bit_cast(float, ((unsigned)b) << 16); }
__device__ __forceinline__ void lds_barrier() { asm volatile("s_waitcnt lgkmcnt(0)" ::: "memory"); __builtin_amdgcn_s_barrier(); asm volatile("" ::: "memory"); }
__device__ __forceinline__ float sigmoidf_(float x) { return __builtin_amdgcn_rcpf(1.0f + __expf(-x)); }
__device__ __forceinline__ float wave_sum(float v) {
#pragma unroll
    for (int o = 1; o < 64; o <<= 1) v += __shfl_xor(v, o);
    return v;
}
__device__ __forceinline__ float dpp_f(float v, const int ctrl_sel) {
    int x = __builtin_bit_cast(int, v), r;
    if (ctrl_sel == 0) r = __builtin_amdgcn_update_dpp(0, x, 0xB1, 0xf, 0xf, true);
    else if (ctrl_sel == 1) r = __builtin_amdgcn_update_dpp(0, x, 0x4E, 0xf, 0xf, true);
    else r = __builtin_amdgcn_update_dpp(0, x, 0x141, 0xf, 0xf, true);
    return __builtin_bit_cast(float, r);
}
__device__ __forceinline__ float red8(float v) { v += dpp_f(v, 0); v += dpp_f(v, 1); v += dpp_f(v, 2); return v; }

#define XB_TMO      128
#define XB_XCNT(j)  (256  + 64 * (j))
#define XB_XSUB(j)  (1280 + 64 * (j))
#define XB_XGEN(j)  (2304 + 64 * (j))
#define XB_TOP      3328
#define XB_TOPGEN   3392
#define XCD_BAR_WORDS 3456
#define XB_SPIN_CAP (1u << 18)
__device__ __forceinline__ unsigned xb_ld(unsigned* p)              { return __hip_atomic_load(p, __ATOMIC_RELAXED, __HIP_MEMORY_SCOPE_AGENT); }
__device__ __forceinline__ unsigned xb_add(unsigned* p, unsigned v) { return __hip_atomic_fetch_add(p, v, __ATOMIC_RELAXED, __HIP_MEMORY_SCOPE_AGENT); }
__device__ __forceinline__ unsigned xb_xcc_id() { return (unsigned)__builtin_amdgcn_s_getreg((3 << 11) | 20) & 0xFu; }
#define XB_SPIN(cond, bar) do { unsigned _sp = 0; while (cond) { __builtin_amdgcn_s_sleep(1); \
    if ((++_sp & 255u) == 0u) { if (xb_ld(&(bar)[XB_TMO])) break; if (_sp > XB_SPIN_CAP) { atomicAdd(&(bar)[XB_TMO], 1u); break; } } } } while (0)
struct XcdBarrier { unsigned* bar; unsigned x; volatile LAS unsigned* st; };
__device__ __forceinline__ XcdBarrier xcd_barrier_post(unsigned* bar, volatile LAS unsigned* st) {
    XcdBarrier b; b.bar = bar; b.x = xb_xcc_id(); b.st = st;
    if (threadIdx.x == 0) (void)xb_add(&bar[XB_XCNT(b.x)], 1u);
    return b;
}
__device__ __forceinline__ void xcd_barrier_complete(unsigned* bar, unsigned x, unsigned& nloc, unsigned& nx) {
    const unsigned G = gridDim.x * gridDim.y * gridDim.z;
    unsigned sum, cnt, mine, sp = 0u;
    for (;;) {
        sum = 0u; cnt = 0u; mine = 0u;
#pragma unroll
        for (unsigned j = 0; j < 16; ++j) { const unsigned c = xb_ld(&bar[XB_XCNT(j)]); sum += c; cnt += (c > 0u) ? 1u : 0u; mine = (j == x) ? c : mine; }
        if (sum == G) break;
        __builtin_amdgcn_s_sleep(1);
        if ((++sp & 255u) == 0u) { if (xb_ld(&bar[XB_TMO])) break; if (sp > XB_SPIN_CAP) { atomicAdd(&bar[XB_TMO], 1u); break; } }
    }
    nloc = mine > 0u ? mine : 1u; nx = cnt > 0u ? cnt : 1u;
}
__device__ __forceinline__ void xcd_barrier(const XcdBarrier& b) {
    asm volatile("s_waitcnt vmcnt(0)" ::: "memory");
    __syncthreads();
    if (threadIdx.x == 0) {
        unsigned* bar = b.bar;
        __builtin_amdgcn_s_waitcnt(0);
        unsigned nloc = b.st[0], nx = b.st[1];
        if (nloc == 0u) { xcd_barrier_complete(bar, b.x, nloc, nx); b.st[0] = nloc; b.st[1] = nx; }
        const unsigned old = xb_add(&bar[XB_XSUB(b.x)], 1u);
        const unsigned gen = old / nloc;
        if (old + 1u == (gen + 1u) * nloc) {
            __builtin_amdgcn_fence(__ATOMIC_RELEASE, "agent");
            asm volatile("s_waitcnt vmcnt(0)" ::: "memory");
            const unsigned og = xb_add(&bar[XB_TOP], 1u);
            const unsigned tg = og / nx;
            if (og + 1u == (tg + 1u) * nx) xb_add(&bar[XB_TOPGEN], 1u);
            else XB_SPIN(xb_ld(&bar[XB_TOPGEN]) == tg, bar);
            __builtin_amdgcn_fence(__ATOMIC_ACQUIRE, "agent");
            xb_add(&bar[XB_XGEN(b.x)], 1u);
            asm volatile("s_waitcnt vmcnt(0)" ::: "memory");
        } else {
            XB_SPIN(xb_ld(&bar[XB_XGEN(b.x)]) == gen, bar);
            __builtin_amdgcn_fence(__ATOMIC_ACQUIRE, "agent");
            asm volatile("s_waitcnt vmcnt(0)" ::: "memory");
        }
    }
    __syncthreads();
}

namespace pg8 {
constexpr int BM = 256, BK = 64, HALF = 128, HTB = HALF * BK * 2, NXCD = 8, WGM = 4;
__device__ __forceinline__ int lds_byte(int r, int c) { const int st = (r >> 4) * 2 + (c >> 5), rr = r & 15, cc = c & 31, ob = rr * 64 + cc * 2; return st * 1024 + (ob ^ (((ob >> 9) & 1) << 5)); }
__device__ __forceinline__ void stage_rc(int b, int& R, int& C) { const int st = b / 1024, sb = b % 1024, swz = sb ^ (((sb >> 9) & 1) << 5); R = (st >> 1) * 16 + swz / 64; C = (st & 1) * 32 + (swz % 64) / 2; }
__device__ __forceinline__ int perm32(int rho) { const int n = rho >> 4, i = rho & 15; return 8 * (i >> 2) + 4 * n + (i & 3); }
__device__ __forceinline__ unsigned cvt_pk_bf16(float lo, float hi) { return pk2(lo, hi); }

struct Unit { int pn, e, row0, pos0; };

struct StaticOrder {
    int nM, nN, nwg, G, c;
    __device__ void init(int M, int N, int G_, int c_) { nM = M / BM; nN = N / BM; nwg = nM * nN; G = G_; c = c_; }
    __device__ __forceinline__ bool next(int i, Unit& u) const {
        const long L = (long)i * G + c; if (L >= nwg) return false;
        int wgid = (int)L; { const int q = nwg / NXCD, r = nwg % NXCD, xcd = wgid % NXCD, off = wgid / NXCD; wgid = (xcd < r ? xcd * (q + 1) : r * (q + 1) + (xcd - r) * q) + off; }
        const int nig = WGM * nN, gid = wgid / nig, fm = gid * WGM, gsz = (nM - fm) < WGM ? (nM - fm) : WGM;
        const int pm = fm + ((wgid % nig) % gsz); u.pn = (wgid % nig) / gsz; u.e = 0; u.row0 = pm * BM; u.pos0 = 0; return true;
    }
};
struct MoeOrder {
    const volatile LAS int* prefix; const volatile LAS int* ebase; int ncol, G, c;
    __device__ __forceinline__ bool next(int i, Unit& u) const {
        const int L = i * G + c; const int total = prefix[NEXP] * ncol; if (L >= total) return false;
        const int tile = L / ncol; u.pn = L - tile * ncol;
        int e = 0;
#pragma unroll 1
        for (int j = 1; j < NEXP; ++j) e += (prefix[j] <= tile) ? 1 : 0;
        u.e = e; u.pos0 = (tile - prefix[e]) * BM; u.row0 = ebase[e] + u.pos0; return true;
    }
};

struct PlainA { static constexpr bool GATHER = false; const char* A; int lda2;    volatile LAS unsigned* rot;
    __device__ __forceinline__ unsigned row_off(const Unit& u, int r) const { return (unsigned)(u.row0 + r) * (unsigned)lda2; } };
struct GatherA { static constexpr bool GATHER = true; const char* A; int lda2; const int* perm; const volatile LAS int* cnt; volatile LAS unsigned* rot;
    __device__ __forceinline__ unsigned row_off(const Unit& u, int r) const { const int pos = u.pos0 + r; const int tok = pos < cnt[u.e] ? perm[(size_t)u.e * T + pos] : 0; return (unsigned)tok * (unsigned)lda2; } };

template <class AP, class Epi, class Sched, bool ALIGN_EPI>
__device__ __forceinline__ void gemm_phase(LAS unsigned char* lds, const AP& P, const char* Bt, const int K, const int Nexp  , const Sched& S, const Epi& E) {
    int tid_ = threadIdx.x; asm volatile("" : "+v"(tid_));
    const int tid = tid_, wid = __builtin_amdgcn_readfirstlane(tid >> 6), lane = tid & 63, wr = wid >> 2, wc = wid & 3, fr = lane & 15, fq = lane >> 4;
    const int nt = K / BK;
    unsigned voffA[2], voffB[2][2];
#pragma unroll
    for (int i = 0; i < 2; ++i) { int R, C; stage_rc(tid * 16 + i * 8192, R, C); voffA[i] = (unsigned)R * (unsigned)P.lda2 + (unsigned)C * 2u;
#pragma unroll
        for (int hb = 0; hb < 2; ++hb) { const int Rb = Epi::WIDE ? (64 * (R >> 5) + 32 * hb + perm32(R & 31)) : (128 * hb + (Epi::PERM ? ((R & ~31) + perm32(R & 31)) : R)); voffB[hb][i] = (unsigned)(Rb * K + C) * 2u; } }
    const size_t kstep = (size_t)(BK * 2);
    const size_t hstepA = (size_t)HALF * P.lda2;
    const unsigned ldsw = (unsigned)wid * 1024u;
    const int aoff = lds_byte(wr * 64 + fr, fq * 8), boff = lds_byte(wc * 32 + fr, fq * 8);
#define PG8_SA(b, h) (((b) * 2 + (h)) * HTB)
#define PG8_SB(b, h) ((4 + (b) * 2 + (h)) * HTB)
#define PG8_STAGE_B(bufoff, hb_, gbase) do { _Pragma("unroll") for (int _i = 0; _i < 2; ++_i) \
        __builtin_amdgcn_global_load_lds((const unsigned*)((const char*)(gbase) + voffB[hb_][_i]), (LAS unsigned*)(lds + (bufoff) + ldsw + _i * 8192), 16, 0, 0); } while (0)
#define PG8_STAGE_A(bufoff, hf, kb) do { _Pragma("unroll") for (int _i = 0; _i < 2; ++_i) { \
        const char* _g; if constexpr (AP::GATHER) _g = P.A + (size_t)(kb) + (P.rot[sslot * 256 + (hf) * HALF + gR0 + 64 * _i] + gC2); else _g = sA + (size_t)(kb) + ((hf) ? hstepA : (size_t)0) + voffA[_i]; \
        __builtin_amdgcn_global_load_lds((const unsigned*)_g, (LAS unsigned*)(lds + (bufoff) + ldsw + _i * 8192), 16, 0, 0); } } while (0)
#define PG8_LDA(dst, b, h) do { _Pragma("unroll") for (int m = 0; m < 4; ++m) _Pragma("unroll") for (int k = 0; k < 2; ++k) dst[m][k] = *(const LAS bf16x8*)(lds + PG8_SA(b, h) + aoff + m * 2048 + k * 1024); } while (0)
#define PG8_LDB(dst, b, h) do { _Pragma("unroll") for (int n = 0; n < 2; ++n) _Pragma("unroll") for (int k = 0; k < 2; ++k) dst[n][k] = *(const LAS bf16x8*)(lds + PG8_SB(b, h) + boff + n * 2048 + k * 1024); } while (0)
#define PG8_MMA(ai, bj, At, Bt_) do { __builtin_amdgcn_s_setprio(1); _Pragma("unroll") for (int m = 0; m < 4; ++m) _Pragma("unroll") for (int n = 0; n < 2; ++n) _Pragma("unroll") for (int k = 0; k < 2; ++k) \
        acc[ai][bj][m][n] = __builtin_amdgcn_mfma_f32_16x16x32_bf16(Bt_[n][k], At[m][k], acc[ai][bj][m][n], 0, 0, 0); __builtin_amdgcn_s_setprio(0); } while (0)
#define PG8_WAIT_V(n) asm volatile("s_waitcnt vmcnt(" #n ")" ::: "memory")
#define PG8_WAIT_L(n) asm volatile("s_waitcnt lgkmcnt(" #n ")" ::: "memory")
#define PG8_BAR __builtin_amdgcn_s_barrier()
#define PG8_SCHED __builtin_amdgcn_sched_barrier(0)
#define PG8_ROWOFFS(u, sl) do { if (tid < 256) P.rot[(sl) * 256 + tid] = P.row_off(u, tid); } while (0)
    int gR0 = 0; unsigned gC2 = 0u; { int R, C; stage_rc(tid * 16, R, C); gR0 = R; gC2 = (unsigned)C * 2u; }
    int sslot = 0;
    Unit cur, nxt; int ui = 0;
    if (!S.next(0, cur)) return;
    f32x4 acc[2][2][4][2];
#pragma unroll
    for (int a = 0; a < 2; ++a)
#pragma unroll
        for (int b = 0; b < 2; ++b)
#pragma unroll
            for (int m = 0; m < 4; ++m)
#pragma unroll
                for (int n = 0; n < 2; ++n) acc[a][b][m][n] = (f32x4){0.f, 0.f, 0.f, 0.f};
    bf16x8 At[4][2], B0[2][2], B1[2][2];
    const char* sA = P.A; const char* sB = Bt + ((size_t)cur.e * Nexp + (size_t)cur.pn * BM) * K * 2;
    if constexpr (AP::GATHER) { PG8_ROWOFFS(cur, 0); __syncthreads(); } else { sA = P.A + (size_t)cur.row0 * P.lda2; }
    PG8_STAGE_B(PG8_SB(0, 0), 0, sB); PG8_STAGE_B(PG8_SB(0, 1), 1, sB); PG8_STAGE_A(PG8_SA(0, 0), 0, 0); PG8_STAGE_A(PG8_SA(0, 1), 1, 0);
    if (wr == 1) PG8_BAR;
    PG8_WAIT_V(2); PG8_BAR;
    PG8_STAGE_B(PG8_SB(1, 0), 0, sB + kstep); PG8_STAGE_A(PG8_SA(1, 0), 0, kstep); PG8_STAGE_B(PG8_SB(1, 1), 1, sB + kstep);
    PG8_WAIT_V(6); PG8_BAR;
    for (;;) {
        const bool has_next = S.next(ui + 1, nxt);
        const char* nB = has_next ? Bt + ((size_t)nxt.e * Nexp + (size_t)nxt.pn * BM) * K * 2 : sB;
        const char* nA = sA;
        if constexpr (AP::GATHER) { if (has_next) { PG8_ROWOFFS(nxt, (ui + 1) & 1); } }
        else { if (has_next) nA = P.A + (size_t)nxt.row0 * P.lda2; }
#pragma unroll 1
        for (int t = 0; t < nt; t += 2) {
            const bool last = (t == nt - 2);
            PG8_LDB(B0, 0, 0); PG8_LDB(B1, 0, 1); PG8_SCHED; PG8_LDA(At, 0, 0); PG8_STAGE_A(PG8_SA(1, 1), 1, (size_t)(t + 1) * kstep);
            PG8_WAIT_V(8); PG8_WAIT_L(0); PG8_BAR; PG8_MMA(0, 0, At, B0); PG8_MMA(0, 1, At, B1); PG8_BAR; PG8_SCHED;
            size_t kb2 = (size_t)(t + 2) * kstep;
            if (last) { kb2 = 0; sB = nB; sA = nA; if (has_next) sslot = (ui + 1) & 1; }
            PG8_LDA(At, 0, 1); PG8_STAGE_B(PG8_SB(0, 0), 0, sB + kb2); PG8_STAGE_B(PG8_SB(0, 1), 1, sB + kb2); PG8_STAGE_A(PG8_SA(0, 0), 0, kb2);
            PG8_WAIT_V(8); PG8_WAIT_L(0); PG8_BAR; PG8_MMA(1, 0, At, B0); PG8_MMA(1, 1, At, B1); PG8_BAR; PG8_SCHED;
            PG8_LDB(B0, 1, 0); PG8_LDB(B1, 1, 1); PG8_SCHED; PG8_LDA(At, 1, 0); PG8_STAGE_A(PG8_SA(0, 1), 1, kb2);
            PG8_WAIT_V(8); PG8_WAIT_L(0); PG8_BAR; PG8_MMA(0, 0, At, B0); PG8_MMA(0, 1, At, B1); PG8_BAR; PG8_SCHED;
            PG8_LDA(At, 1, 1); PG8_STAGE_B(PG8_SB(1, 0), 0, sB + kb2 + kstep); PG8_STAGE_B(PG8_SB(1, 1), 1, sB + kb2 + kstep); PG8_STAGE_A(PG8_SA(1, 0), 0, kb2 + kstep);
            PG8_WAIT_V(8); PG8_WAIT_L(0); PG8_BAR; PG8_MMA(1, 0, At, B0); PG8_MMA(1, 1, At, B1); PG8_BAR; PG8_SCHED;
        }
        if constexpr (ALIGN_EPI) { if (wr == 0) PG8_BAR; }
        E(acc, cur, wr, wc, fr, fq);
        if (!has_next) break;
#pragma unroll
        for (int a = 0; a < 2; ++a)
#pragma unroll
            for (int b = 0; b < 2; ++b)
#pragma unroll
                for (int m = 0; m < 4; ++m)
#pragma unroll
                    for (int n = 0; n < 2; ++n) acc[a][b][m][n] = (f32x4){0.f, 0.f, 0.f, 0.f};
        cur = nxt; ++ui;
        if constexpr (ALIGN_EPI) { if (wr == 1) PG8_BAR; }
    }
    PG8_WAIT_V(0);
    if constexpr (!ALIGN_EPI) { if (wr == 0) PG8_BAR; }
    PG8_BAR;
#undef PG8_SA
#undef PG8_SB
#undef PG8_STAGE_A
#undef PG8_STAGE_B
#undef PG8_LDA
#undef PG8_LDB
#undef PG8_MMA
#undef PG8_WAIT_V
#undef PG8_WAIT_L
#undef PG8_BAR
#undef PG8_SCHED
#undef PG8_ROWOFFS
}

typedef const f32x4 (&AccRef)[2][2][4][2];
__device__ __forceinline__ unsigned ror8(unsigned x) { return (unsigned)__builtin_amdgcn_update_dpp(0, (int)x, 0x128, 0xf, 0xf, false); }
__device__ __forceinline__ u32x4 ror8v(u32x4 v) { return (u32x4){ror8(v.x), ror8(v.y), ror8(v.z), ror8(v.w)}; }
__device__ __forceinline__ void wide_swap(u32x4 p0, u32x4 p1, int fr, u32x4& q0, u32x4& q1) {
    const bool lo = fr < 8; const u32x4 snd = lo ? p1 : p0; const u32x4 rcv = ror8v(snd);
    q0 = lo ? p0 : rcv; q1 = lo ? rcv : p1;
}
struct EpiZ { static constexpr bool PERM = true, WIDE = true; bf16* Zr; bf16* Za; const float* rstd;
    __device__ __forceinline__ void operator()(AccRef acc, const Unit& u, int wr, int wc, int fr, int fq) const {
        bf16* base; int ldc, colt;
        if (u.pn < 7) { base = Zr; ldc = NR; colt = u.pn * BM; } else { base = Za; ldc = NA; colt = (u.pn - 7) * BM; }
        const int col0 = colt + wc * 64 + (fr >> 3) * 32 + 8 * fq;
        float sv[2][4];
#pragma unroll
        for (int ai = 0; ai < 2; ++ai)
#pragma unroll
            for (int m = 0; m < 4; ++m) sv[ai][m] = rstd[u.row0 + ai * HALF + wr * 64 + m * 16 + fr];
#pragma unroll
        for (int ai = 0; ai < 2; ++ai)
#pragma unroll
            for (int m = 0; m < 4; ++m) { const int rb = u.row0 + ai * HALF + wr * 64 + m * 16; const float s = sv[ai][m];
                const f32x4 a0 = acc[ai][0][m][0] * s, a1 = acc[ai][0][m][1] * s, b0 = acc[ai][1][m][0] * s, b1 = acc[ai][1][m][1] * s;
                u32x4 p0, p1, q0, q1; p0.x = cvt_pk_bf16(a0[0], a0[1]); p0.y = cvt_pk_bf16(a0[2], a0[3]); p0.z = cvt_pk_bf16(a1[0], a1[1]); p0.w = cvt_pk_bf16(a1[2], a1[3]);
                p1.x = cvt_pk_bf16(b0[0], b0[1]); p1.y = cvt_pk_bf16(b0[2], b0[3]); p1.z = cvt_pk_bf16(b1[0], b1[1]); p1.w = cvt_pk_bf16(b1[2], b1[3]);
                wide_swap(p0, p1, fr, q0, q1);
                bf16* rp = base + (size_t)(rb + (fr & 7)) * ldc + col0; *(u32x4*)rp = q0; *(u32x4*)(rp + (size_t)8 * ldc) = q1; }
    }
};
struct EpiB { static constexpr bool PERM = true, WIDE = true; bf16* O; int ldc;
    __device__ __forceinline__ void operator()(AccRef acc, const Unit& u, int wr, int wc, int fr, int fq) const {
        const int col0 = u.pn * BM + wc * 64 + (fr >> 3) * 32 + 8 * fq;
#pragma unroll
        for (int ai = 0; ai < 2; ++ai)
#pragma unroll
            for (int m = 0; m < 4; ++m) { const int rb = u.row0 + ai * HALF + wr * 64 + m * 16;
                const f32x4 a0 = acc[ai][0][m][0], a1 = acc[ai][0][m][1], b0 = acc[ai][1][m][0], b1 = acc[ai][1][m][1];
                u32x4 p0, p1, q0, q1; p0.x = cvt_pk_bf16(a0[0], a0[1]); p0.y = cvt_pk_bf16(a0[2], a0[3]); p0.z = cvt_pk_bf16(a1[0], a1[1]); p0.w = cvt_pk_bf16(a1[2], a1[3]);
                p1.x = cvt_pk_bf16(b0[0], b0[1]); p1.y = cvt_pk_bf16(b0[2], b0[3]); p1.z = cvt_pk_bf16(b1[0], b1[1]); p1.w = cvt_pk_bf16(b1[2], b1[3]);
                wide_swap(p0, p1, fr, q0, q1);
                bf16* rp = O + (size_t)(rb + (fr & 7)) * ldc + col0; *(u32x4*)rp = q0; *(u32x4*)(rp + (size_t)8 * ldc) = q1; }
    }
};
__device__ __forceinline__ u32x4 add_bf16x8(u32x4 h, u32x4 d) {
    u32x4 o; o.x = cvt_pk_bf16(bf_lo(h.x) + bf_lo(d.x), bf_hi(h.x) + bf_hi(d.x)); o.y = cvt_pk_bf16(bf_lo(h.y) + bf_lo(d.y), bf_hi(h.y) + bf_hi(d.y));
    o.z = cvt_pk_bf16(bf_lo(h.z) + bf_lo(d.z), bf_hi(h.z) + bf_hi(d.z)); o.w = cvt_pk_bf16(bf_lo(h.w) + bf_lo(d.w), bf_hi(h.w) + bf_hi(d.w)); return o; }
struct EpiRes { static constexpr bool PERM = true, WIDE = true; bf16* h;
    __device__ __forceinline__ void operator()(AccRef acc, const Unit& u, int wr, int wc, int fr, int fq) const {
        const int col0 = u.pn * BM + wc * 64 + (fr >> 3) * 32 + 8 * fq; const bool lo = fr < 8;
#pragma unroll
        for (int ai = 0; ai < 2; ++ai) {
            u32x4 hv0[4], hv1[4];
#pragma unroll
            for (int m = 0; m < 4; ++m) { const bf16* rp = h + (size_t)(u.row0 + ai * HALF + wr * 64 + m * 16 + (fr & 7)) * D + col0; hv0[m] = *(const u32x4*)rp; hv1[m] = *(const u32x4*)(rp + (size_t)8 * D); }
#pragma unroll
            for (int m = 0; m < 4; ++m) { const int rb = u.row0 + ai * HALF + wr * 64 + m * 16; bf16* rp = h + (size_t)(rb + (fr & 7)) * D + col0;
                const u32x4 h0 = hv0[m], h1 = hv1[m];
                const f32x4 a0 = acc[ai][0][m][0], a1 = acc[ai][0][m][1], b0 = acc[ai][1][m][0], b1 = acc[ai][1][m][1];
                u32x4 snd; { const f32x4 s0 = lo ? b0 : a0, s1 = lo ? b1 : a1; snd.x = cvt_pk_bf16(s0[0], s0[1]); snd.y = cvt_pk_bf16(s0[2], s0[3]); snd.z = cvt_pk_bf16(s1[0], s1[1]); snd.w = cvt_pk_bf16(s1[2], s1[3]); }
                const u32x4 rcv = ror8v(snd);
                const f32x4 k0 = lo ? a0 : b0, k1 = lo ? a1 : b1;
                const u32x4 hk = lo ? h0 : h1, hr_ = lo ? h1 : h0;
                u32x4 ok; ok.x = cvt_pk_bf16(bf_lo(hk.x) + k0[0], bf_hi(hk.x) + k0[1]); ok.y = cvt_pk_bf16(bf_lo(hk.y) + k0[2], bf_hi(hk.y) + k0[3]); ok.z = cvt_pk_bf16(bf_lo(hk.z) + k1[0], bf_hi(hk.z) + k1[1]); ok.w = cvt_pk_bf16(bf_lo(hk.w) + k1[2], bf_hi(hk.w) + k1[3]);
                const u32x4 orr = add_bf16x8(hr_, rcv);
                *(u32x4*)rp = lo ? ok : orr; *(u32x4*)(rp + (size_t)8 * D) = lo ? orr : ok; }
        }
    }
};
struct EpiPle { static constexpr bool PERM = true, WIDE = true; const bf16* hin; bf16* hout; const bf16* PP; const float* rstd; const float* bg;
    __device__ __forceinline__ void operator()(AccRef acc, const Unit& u, int wr, int wc, int fr, int fq) const {
        const int colw = u.pn * BM + wc * 64 + 8 * fq; const int col0 = colw + (fr >> 3) * 32;
        const f32x4 g00 = *(const f32x4*)(bg + colw), g01 = *(const f32x4*)(bg + colw + 4), g10 = *(const f32x4*)(bg + colw + 32), g11 = *(const f32x4*)(bg + colw + 36);
        float sv[2][4];
#pragma unroll
        for (int ai = 0; ai < 2; ++ai)
#pragma unroll
            for (int m = 0; m < 4; ++m) sv[ai][m] = rstd[u.row0 + ai * HALF + wr * 64 + m * 16 + fr];
#pragma unroll
        for (int am = 0; am < 4; ++am) { const int ai = am >> 1;
            u32x4 hv0[2], hv1[2], pv0[2], pv1[2];
#pragma unroll
            for (int mm = 0; mm < 2; ++mm) { const int m = (am & 1) * 2 + mm; const size_t off = (size_t)(u.row0 + ai * HALF + wr * 64 + m * 16 + (fr & 7)) * D + col0;
                hv0[mm] = *(const u32x4*)(hin + off); hv1[mm] = *(const u32x4*)(hin + off + (size_t)8 * D); pv0[mm] = *(const u32x4*)(PP + off); pv1[mm] = *(const u32x4*)(PP + off + (size_t)8 * D); }
#pragma unroll
            for (int mm = 0; mm < 2; ++mm) { const int m = (am & 1) * 2 + mm; const int rb = u.row0 + ai * HALF + wr * 64 + m * 16; const float s = sv[ai][m]; const size_t off = (size_t)(rb + (fr & 7)) * D + col0;
                const u32x4 h0 = hv0[mm], h1 = hv1[mm], pp0 = pv0[mm], pp1 = pv1[mm];
                const f32x4 a0 = acc[ai][0][m][0] * s + g00, a1 = acc[ai][0][m][1] * s + g01, b0 = acc[ai][1][m][0] * s + g10, b1 = acc[ai][1][m][1] * s + g11;
                u32x4 p0, p1, q0, q1;
                p0.x = cvt_pk_bf16(sigmoidf_(a0[0]), sigmoidf_(a0[1])); p0.y = cvt_pk_bf16(sigmoidf_(a0[2]), sigmoidf_(a0[3])); p0.z = cvt_pk_bf16(sigmoidf_(a1[0]), sigmoidf_(a1[1])); p0.w = cvt_pk_bf16(sigmoidf_(a1[2]), sigmoidf_(a1[3]));
                p1.x = cvt_pk_bf16(sigmoidf_(b0[0]), sigmoidf_(b0[1])); p1.y = cvt_pk_bf16(sigmoidf_(b0[2]), sigmoidf_(b0[3])); p1.z = cvt_pk_bf16(sigmoidf_(b1[0]), sigmoidf_(b1[1])); p1.w = cvt_pk_bf16(sigmoidf_(b1[2]), sigmoidf_(b1[3]));
                wide_swap(p0, p1, fr, q0, q1);
#define PLE_OUT(hv, gv, pv) ((u32x4){cvt_pk_bf16(bf_lo(hv.x) + bf_lo(gv.x) * bf_lo(pv.x), bf_hi(hv.x) + bf_hi(gv.x) * bf_hi(pv.x)), cvt_pk_bf16(bf_lo(hv.y) + bf_lo(gv.y) * bf_lo(pv.y), bf_hi(hv.y) + bf_hi(gv.y) * bf_hi(pv.y)), \
                                     cvt_pk_bf16(bf_lo(hv.z) + bf_lo(gv.z) * bf_lo(pv.z), bf_hi(hv.z) + bf_hi(gv.z) * bf_hi(pv.z)), cvt_pk_bf16(bf_lo(hv.w) + bf_lo(gv.w) * bf_lo(pv.w), bf_hi(hv.w) + bf_hi(gv.w) * bf_hi(pv.w))})
                *(u32x4*)(hout + off) = PLE_OUT(h0, q0, pp0); *(u32x4*)(hout + off + (size_t)8 * D) = PLE_OUT(h1, q1, pp1);
#undef PLE_OUT
            }
        }
    }
};
struct EpiHid { static constexpr bool PERM = true, WIDE = false; bf16* HID; const float* srs; const float* scw; const volatile LAS int* cnt;
    __device__ __forceinline__ void operator()(AccRef acc, const Unit& u, int wr, int wc, int fr, int fq) const {
        const int rl0 = wr * 64 + fr; const int col0 = u.pn * HALF + wc * 32 + 8 * fq; const int ce = cnt[u.e];
        float rsv[2][4], cwv[2][4];
#pragma unroll
        for (int ai = 0; ai < 2; ++ai)
#pragma unroll
            for (int m = 0; m < 4; ++m) { int pos = u.pos0 + rl0 + ai * HALF + m * 16; const bool ok = pos < ce; pos = ok ? pos : 0; const float r_ = srs[(size_t)u.e * T + pos], c_ = scw[(size_t)u.e * T + pos]; rsv[ai][m] = ok ? r_ : 0.f; cwv[ai][m] = ok ? c_ : 0.f; }
#pragma unroll
        for (int ai = 0; ai < 2; ++ai)
#pragma unroll
            for (int m = 0; m < 4; ++m) { const int rl = rl0 + ai * HALF + m * 16;
                const float rs = rsv[ai][m], cw = cwv[ai][m];
                float o[8];
#pragma unroll
                for (int n = 0; n < 2; ++n)
#pragma unroll
                    for (int j = 0; j < 4; ++j) { const float g = acc[ai][0][m][n][j] * rs, up = acc[ai][1][m][n][j] * rs; o[n * 4 + j] = g * sigmoidf_(g) * up * cw; }
                u32x4 w; w.x = cvt_pk_bf16(o[0], o[1]); w.y = cvt_pk_bf16(o[2], o[3]); w.z = cvt_pk_bf16(o[4], o[5]); w.w = cvt_pk_bf16(o[6], o[7]);
                *(u32x4*)(HID + (size_t)(u.row0 + rl) * 256 + col0) = w; }
    }
};
}

struct Args { const float* in[33]; float* out; unsigned char* ws; int ph_lo, ph_hi; };
typedef const Args __attribute__((address_space(4)))* ArgsP;
#define H_A(ap_) ((bf16*)((ap_)->ws + WS_XB))
#define H_B(ap_) ((bf16*)((unsigned char*)(ap_)->out + 64 * MiB))
#define H_CUR(ap_, L_) ((L_) == 0 ? H_A(ap_) : H_B(ap_))
#define H_NXT(ap_, L_) ((L_) == 0 ? H_B(ap_) : H_A(ap_))
#define P_R(ap_) ((bf16*)(ap_)->out)
#define P_K(ap_) ((bf16*)((unsigned char*)(ap_)->out + 32 * MiB))
__device__ __forceinline__ ArgsP args_ptr() { ArgsP p = (ArgsP)__builtin_amdgcn_kernarg_segment_ptr(); asm volatile("" : "+s"(p)); return p; }
enum { I_X = 0, I_P, I_NMIX, I_WIN, I_MU, I_W0, I_W2, I_A0, I_A2, I_G2, I_KK, I_KA, I_RK, I_LNW, I_LNB, I_V0, I_V1, I_V2, I_RELB, I_WOUT, I_NFFN, I_RGW, I_RGB, I_REW, I_REB,
       I_EW1, I_EW3, I_EW2, I_NPLE, I_PGW, I_PGB, I_PPW, I_FNW };

__device__ __forceinline__ void transpose_item(const float* W, int ldw, int k0, int n0, const float* scale, bf16* WT, int ldt, int drow0, LAS float* scr, int lane) {
    const int ln = lane & 7, lk = lane >> 3;
    f32x4 v[8];
#pragma unroll
    for (int i = 0; i < 8; ++i) v[i] = *(const f32x4*)(W + (size_t)(k0 + lk + 8 * i) * ldw + n0 + 4 * ln);
    if (scale) {
#pragma unroll
        for (int i = 0; i < 8; ++i) v[i] = v[i] * scale[k0 + lk + 8 * i];
    }
#pragma unroll
    for (int i = 0; i < 8; ++i) { LAS float* d = scr + (lk + 8 * i) * 33 + 4 * ln; d[0] = v[i][0]; d[1] = v[i][1]; d[2] = v[i][2]; d[3] = v[i][3]; }
    asm volatile("s_waitcnt lgkmcnt(0)" ::: "memory");
    const int c = lane & 7;
#pragma unroll
    for (int j = 0; j < 4; ++j) { const int n = (lane >> 3) + 8 * j; const LAS float* s = scr + (8 * c) * 33 + n;
        u32x4 o; o.x = pk2(s[0 * 33], s[1 * 33]); o.y = pk2(s[2 * 33], s[3 * 33]); o.z = pk2(s[4 * 33], s[5 * 33]); o.w = pk2(s[6 * 33], s[7 * 33]);
        *(u32x4*)(WT + (size_t)(drow0 + n) * ldt + k0 + 8 * c) = o; }
    asm volatile("s_waitcnt lgkmcnt(0)" ::: "memory");
}
__device__ __forceinline__ void row_to_bf16_rstd(const float* xrow, bf16* orow, float* rstd_out, int lane) {
    const f32x4* xr = (const f32x4*)xrow + lane; f32x4 v[4]; float s = 0.f;
#pragma unroll
    for (int j = 0; j < 4; ++j) { v[j] = xr[64 * j]; s += (v[j].x * v[j].x + v[j].y * v[j].y) + (v[j].z * v[j].z + v[j].w * v[j].w); }
    s = wave_sum(s);
    if (lane == 0) *rstd_out = 1.0f / sqrtf(s * (1.0f / D) + RMS_EPS);
    u32x2* o8 = (u32x2*)orow + lane;
#pragma unroll
    for (int j = 0; j < 4; ++j) { u32x2 w; w.x = pk2(v[j].x, v[j].y); w.y = pk2(v[j].z, v[j].w); o8[64 * j] = w; }
}

constexpr int CONV_SPLIT = 6144;
__device__ __forceinline__ void phase_convert(ArgsP a, int L, LAS unsigned char* lds, int gw, int NGW, int wave, int lane, const float* hsrc, int it_lo, int it_hi, bool rest) {
    unsigned char* ws = a->ws;
    LAS float* scr = (LAS float*)(lds + wave * 16384);
    bf16* Wb = (bf16*)(ws + WS_W);
    constexpr int I_IN = 16 * 104, I_OUT = 16 * 32, I_E13 = 32 * 16 * 8, I_E2 = 32 * 4 * 32, I_PG = 16 * 32, I_PPI = 4 * 32;
    constexpr int NITEMS = I_IN + I_OUT + 2 * I_E13 + I_E2 + I_PG + I_PPI;
    if (it_hi > NITEMS) it_hi = NITEMS;
    for (int it = it_lo + gw; it < it_hi; it += NGW) {
        int r = it;
        if (r < I_IN) { const int kb = r / 104, nb = r % 104; transpose_item(a->in[I_WIN] + (size_t)L * D * NIN, NIN, kb * 64, nb * 32, a->in[I_NMIX] + L * D, (bf16*)((char*)Wb + W_IN), D, nb * 32, scr, lane); continue; } r -= I_IN;
        if (r < I_OUT) { const int kb = r / 32, nb = r % 32; transpose_item(a->in[I_WOUT] + (size_t)L * D * D, D, kb * 64, nb * 32, nullptr, (bf16*)((char*)Wb + W_OUT), D, nb * 32, scr, lane); continue; } r -= I_OUT;
        if (r < 2 * I_E13) { const int which = r / I_E13; r -= which * I_E13; const int e = r / 128, q = r % 128, kb = q / 8, nb = q % 8;
            const float* W = (which ? a->in[I_EW3] : a->in[I_EW1]) + ((size_t)L * NEXP + e) * D * 256; const int n0 = nb * 32; const int pn = n0 >> 7;
            transpose_item(W, 256, kb * 64, n0, a->in[I_NFFN] + L * D, (bf16*)((char*)Wb + W_13), D, (e * 2 + pn) * 256 + which * 128 + (n0 & 127), scr, lane); continue; } r -= 2 * I_E13;
        if (r < I_E2) { const int e = r / 128, q = r % 128, kb = q / 32, nb = q % 32;
            transpose_item(a->in[I_EW2] + ((size_t)L * NEXP + e) * 256 * D, D, kb * 64, nb * 32, nullptr, (bf16*)((char*)Wb + W_2), 256, e * D + nb * 32, scr, lane); continue; } r -= I_E2;
        if (r < I_PG) { const int kb = r / 32, nb = r % 32; transpose_item(a->in[I_PGW] + (size_t)L * D * D, D, kb * 64, nb * 32, a->in[I_NPLE] + L * D, (bf16*)((char*)Wb + W_PG), D, nb * 32, scr, lane); continue; } r -= I_PG;
        { const int kb = r / 32, nb = r % 32; transpose_item(a->in[I_PPW] + (size_t)L * 256 * D, D, kb * 64, nb * 32, nullptr, (bf16*)((char*)Wb + W_PP), 256, nb * 32, scr, lane); }
    }
    if (!rest) return;
    const int gt = gw * 64 + lane, NGT = NGW * 64;
    bf16* WRH = (bf16*)(ws + WS_TAB + TAB_WRH); bf16* WRL = (bf16*)(ws + WS_TAB + TAB_WRL);
    for (int i = gt; i < 48 * D; i += NGT) { const int n = i >> 10, k = i & 1023; float v = 0.f;
        if (n < 4) v = a->in[I_RGW][((size_t)L * D + k) * 4 + n]; else if (n < 36) v = a->in[I_REW][((size_t)L * D + k) * 32 + (n - 4)];
        v *= a->in[I_NFFN][L * D + k]; const unsigned hi = f2bf(v); const float lo = v - __builtin_bit_cast(float, hi << 16); WRH[i] = (bf16)hi; WRL[i] = (bf16)f2bf(lo); }
    bf16* w2t = (bf16*)(ws + WS_TAB + TAB_W2T); bf16* a2t = (bf16*)(ws + WS_TAB + TAB_A2T); bf16* g2t = (bf16*)(ws + WS_TAB + TAB_G2T); bf16* v2t = (bf16*)(ws + WS_TAB + TAB_V2T); bf16* v1t = (bf16*)(ws + WS_TAB + TAB_V1T);
    for (int i = gt; i < 512 * 64; i += NGT) { const int n = i >> 6, k = i & 63; w2t[i] = (bf16)f2bf(a->in[I_W2][((size_t)L * 64 + k) * 512 + n]); a2t[i] = (bf16)f2bf(a->in[I_A2][((size_t)L * 64 + k) * 512 + n]); }
    for (int i = gt; i < 512 * 128; i += NGT) { const int n = i >> 7, k = i & 127; g2t[i] = (bf16)f2bf(a->in[I_G2][((size_t)L * 128 + k) * 512 + n]); }
    if (L > 0) {
        for (int i = gt; i < 512 * 32; i += NGT) { const int n = i >> 5, k = i & 31; v2t[i] = (bf16)f2bf(a->in[I_V2][((size_t)(L - 1) * 32 + k) * 512 + n]); }
        for (int i = gt; i < 32 * 512; i += NGT) { const int n = i >> 9, k = i & 511; v1t[i] = (bf16)f2bf(a->in[I_V1][((size_t)(L - 1) * 512 + k) * 32 + n]); }
    }
    float* RSTD = (float*)(ws + WS_RSTD);
    if (L == 0) { bf16* HA = H_A(a);
        for (int m = gw * 2; m < T; m += NGW * 2) {
            const f32x4* x0 = (const f32x4*)(hsrc + (size_t)m * D) + lane; const f32x4* x1 = x0 + D / 4; f32x4 v0[4], v1[4];
#pragma unroll
            for (int j = 0; j < 4; ++j) { v0[j] = x0[64 * j]; v1[j] = x1[64 * j]; }
            float s0 = 0.f, s1 = 0.f;
#pragma unroll
            for (int j = 0; j < 4; ++j) { s0 += (v0[j].x * v0[j].x + v0[j].y * v0[j].y) + (v0[j].z * v0[j].z + v0[j].w * v0[j].w); s1 += (v1[j].x * v1[j].x + v1[j].y * v1[j].y) + (v1[j].z * v1[j].z + v1[j].w * v1[j].w); }
            s0 = wave_sum(s0); s1 = wave_sum(s1);
            if (lane == 0) { RSTD[m] = 1.0f / sqrtf(s0 * (1.0f / D) + RMS_EPS); RSTD[m + 1] = 1.0f / sqrtf(s1 * (1.0f / D) + RMS_EPS); }
            u32x2* o0 = (u32x2*)(HA + (size_t)m * D) + lane; u32x2* o1 = o0 + D / 4;
#pragma unroll
            for (int j = 0; j < 4; ++j) { u32x2 w; w.x = pk2(v0[j].x, v0[j].y); w.y = pk2(v0[j].z, v0[j].w); o0[64 * j] = w; w.x = pk2(v1[j].x, v1[j].y); w.y = pk2(v1[j].z, v1[j].w); o1[64 * j] = w; } } }
    else { const bf16* HB = H_B(a);
        for (int m = gw * 4; m < T; m += NGW * 4) { u32x4 w[4][2];
#pragma unroll
            for (int r = 0; r < 4; ++r) { const u32x4* hr = (const u32x4*)(HB + (size_t)(m + r) * D) + lane; w[r][0] = hr[0]; w[r][1] = hr[64]; }
            float sq[4];
#pragma unroll
            for (int r = 0; r < 4; ++r) { sq[r] = 0.f;
#pragma unroll
                for (int j = 0; j < 2; ++j) { const unsigned ww[4] = {w[r][j].x, w[r][j].y, w[r][j].z, w[r][j].w};
#pragma unroll
                    for (int q = 0; q < 4; ++q) { const float x0 = bf_lo(ww[q]), x1 = bf_hi(ww[q]); sq[r] += x0 * x0 + x1 * x1; } }
                sq[r] = wave_sum(sq[r]); }
            if (lane == 0) {
#pragma unroll
                for (int r = 0; r < 4; ++r) RSTD[m + r] = 1.0f / sqrtf(sq[r] * (1.0f / D) + RMS_EPS); } } }
}

__device__ __forceinline__ bf16x8 lds_frag(const LAS bf16* base, int stride, int row, int k0) { return *(const LAS bf16x8*)(base + row * stride + k0); }
__device__ __forceinline__ void phase_prep(ArgsP a, int L, LAS unsigned char* lds, int tid, int wave, int lane, int skip) {
    unsigned char* ws = a->ws;
    const bf16* Zr = (const bf16*)(ws + WS_ZR);
    bf16* PR = P_R(a); bf16* PK = P_K(a); bf16* PV = (bf16*)(ws + (L == 0 ? WS_VF : WS_PV)); bf16* PA = (bf16*)(ws + WS_PA); bf16* PG = (bf16*)(ws + WS_PG); bf16* PL = (bf16*)(ws + WS_PL);
    const bf16* VF = (const bf16*)(ws + WS_VF);
    const bf16* w2t = (const bf16*)(ws + WS_TAB + TAB_W2T); const bf16* a2t = (const bf16*)(ws + WS_TAB + TAB_A2T); const bf16* g2t = (const bf16*)(ws + WS_TAB + TAB_G2T);
    const bf16* v2t = (const bf16*)(ws + WS_TAB + TAB_V2T); const bf16* v1t = (const bf16*)(ws + WS_TAB + TAB_V1T);
    const float* mu = a->in[I_MU] + (size_t)L * NR;
    const float* w0 = a->in[I_W0] + L * 512; const float* a0 = a->in[I_A0] + L * 512; const float* v0 = a->in[I_V0];
    constexpr int SW = 72, SG = 136, SV = 520, SVV = 40;
    LAS bf16* AW = (LAS bf16*)lds; LAS bf16* AA = AW + 64 * SW; LAS bf16* AG = AA + 64 * SW; LAS bf16* AV = AG + 64 * SG; LAS bf16* VV = AV + 64 * SV;
    const int fr = lane & 15, fq = lane >> 4;
    for (int tile = blockIdx.x; tile < T / 64; tile += gridDim.x) {
        const int t0 = tile * 64;
        __syncthreads();
        {
            const int tt = tid >> 3, ch = tid & 7, t = t0 + tt; const bool first = (t % SEQ) == 0;
            const bf16* zc = Zr + (size_t)t * NR + 1536 + ch * 32; const bf16* zp = zc - NR;
#pragma unroll
            for (int q = 0; q < 4; ++q) {
                const u32x4 c4 = *(const u32x4*)(zc + q * 8); u32x4 p4 = (u32x4){0u, 0u, 0u, 0u}; if (!first) p4 = *(const u32x4*)(zp + q * 8);
                const f32x4 m0 = *(const f32x4*)(mu + 1536 + ch * 32 + q * 8), m1 = *(const f32x4*)(mu + 1536 + ch * 32 + q * 8 + 4);
                float z[8];
                const unsigned cw[4] = {c4.x, c4.y, c4.z, c4.w}, pw[4] = {p4.x, p4.y, p4.z, p4.w};
#pragma unroll
                for (int j = 0; j < 4; ++j) { const float c0 = bf_lo(cw[j]), c1 = bf_hi(cw[j]), p0 = bf_lo(pw[j]), p1 = bf_hi(pw[j]);
                    const float ma = (j < 2) ? m0[2 * j] : m1[2 * j - 4], mb = (j < 2) ? m0[2 * j + 1] : m1[2 * j - 3];
                    z[2 * j] = c0 + (p0 - c0) * ma; z[2 * j + 1] = c1 + (p1 - c1) * mb; }
                if (ch < 2) {
#pragma unroll
                    for (int j = 0; j < 8; ++j) z[j] = tanhf(z[j]);
                } else if (ch >= 4) {
#pragma unroll
                    for (int j = 0; j < 8; ++j) z[j] = sigmoidf_(z[j]);
                }
                u32x4 o; o.x = pk2(z[0], z[1]); o.y = pk2(z[2], z[3]); o.z = pk2(z[4], z[5]); o.w = pk2(z[6], z[7]);
                LAS bf16* dst = (ch < 2) ? (AW + tt * SW + ch * 32 + q * 8) : (ch < 4) ? (AA + tt * SW + (ch - 2) * 32 + q * 8) : (AG + tt * SG + (ch - 4) * 32 + q * 8);
                *(LAS u32x4*)dst = o;
            }
            if (L > 0) {
                const bf16* vc = Zr + (size_t)t * NR + 1024 + ch * 64; const bf16* vp = vc - NR;
#pragma unroll
                for (int q = 0; q < 8; ++q) {
                    const u32x4 c4 = *(const u32x4*)(vc + q * 8); u32x4 p4 = (u32x4){0u, 0u, 0u, 0u}; if (!first) p4 = *(const u32x4*)(vp + q * 8);
                    const f32x4 m0 = *(const f32x4*)(mu + 1024 + ch * 64 + q * 8), m1 = *(const f32x4*)(mu + 1024 + ch * 64 + q * 8 + 4);
                    float z[8]; const unsigned cw[4] = {c4.x, c4.y, c4.z, c4.w}, pw[4] = {p4.x, p4.y, p4.z, p4.w};
#pragma unroll
                    for (int j = 0; j < 4; ++j) { const float c0 = bf_lo(cw[j]), c1 = bf_hi(cw[j]), p0 = bf_lo(pw[j]), p1 = bf_hi(pw[j]);
                        const float ma = (j < 2) ? m0[2 * j] : m1[2 * j - 4], mb = (j < 2) ? m0[2 * j + 1] : m1[2 * j - 3];
                        z[2 * j] = c0 + (p0 - c0) * ma; z[2 * j + 1] = c1 + (p1 - c1) * mb; }
                    u32x4 o; o.x = pk2(z[0], z[1]); o.y = pk2(z[2], z[3]); o.z = pk2(z[4], z[5]); o.w = pk2(z[6], z[7]);
                    *(LAS u32x4*)(AV + tt * SV + ch * 64 + q * 8) = o;
                }
            }
        }
        __syncthreads();
        if (L > 0) {
            const int m = wave & 3, nt2 = wave >> 2; f32x4 c = (f32x4){0.f, 0.f, 0.f, 0.f};
#pragma unroll 4
            for (int ks = 0; ks < 16; ++ks) { const bf16x8 wf = *(const bf16x8*)(v1t + (size_t)(nt2 * 16 + fr) * 512 + ks * 32 + fq * 8); const bf16x8 af = lds_frag(AV, SV, m * 16 + fr, ks * 32 + fq * 8);
                c = __builtin_amdgcn_mfma_f32_16x16x32_bf16(wf, af, c, 0, 0, 0); }
            u32x2 o; o.x = pk2(c[0], c[1]); o.y = pk2(c[2], c[3]);
            *(LAS u32x2*)(VV + (m * 16 + fr) * SVV + nt2 * 16 + fq * 4) = o;
            __syncthreads();
        }
#pragma unroll
        for (int which = 0; which < 3; ++which) { if (skip == 1) continue;
            f32x4 acc[4][4];
#pragma unroll
            for (int m = 0; m < 4; ++m)
#pragma unroll
                for (int nt = 0; nt < 4; ++nt) acc[m][nt] = (f32x4){0.f, 0.f, 0.f, 0.f};
            const int KS = (which == 2) ? 4 : 2; const bf16* wt = (which == 0) ? w2t : (which == 1) ? a2t : g2t; const int ldw = (which == 2) ? 128 : 64;
            const LAS bf16* Ab = (which == 0) ? AW : (which == 1) ? AA : AG; const int sa = (which == 2) ? SG : SW;
#pragma unroll
            for (int ks = 0; ks < KS; ++ks) {
                bf16x8 af[4];
#pragma unroll
                for (int m = 0; m < 4; ++m) af[m] = lds_frag(Ab, sa, m * 16 + fr, ks * 32 + fq * 8);
#pragma unroll
                for (int nt = 0; nt < 4; ++nt) { const bf16x8 wf = *(const bf16x8*)(wt + (size_t)(wave * 64 + nt * 16 + fr) * ldw + ks * 32 + fq * 8);
#pragma unroll
                    for (int m = 0; m < 4; ++m) acc[m][nt] = __builtin_amdgcn_mfma_f32_16x16x32_bf16(wf, af[m], acc[m][nt], 0, 0, 0); }
            }
#pragma unroll
            for (int m = 0; m < 4; ++m)
#pragma unroll
                for (int nt = 0; nt < 4; ++nt) { const int t = t0 + m * 16 + fr, n0 = wave * 64 + nt * 16 + fq * 4; f32x4 v = acc[m][nt]; u32x2 o;
                    if (which == 0) { const f32x4 b = *(const f32x4*)(w0 + n0);
#pragma unroll
                        for (int j = 0; j < 4; ++j) v[j] = -0.6065306597f * sigmoidf_(v[j] + b[j]);
                        o.x = pk2(v[0], v[1]); o.y = pk2(v[2], v[3]); *(u32x2*)(PL + (size_t)t * 512 + n0) = o; }
                    else if (which == 1) { const f32x4 b = *(const f32x4*)(a0 + n0);
#pragma unroll
                        for (int j = 0; j < 4; ++j) v[j] = sigmoidf_(v[j] + b[j]);
                        o.x = pk2(v[0], v[1]); o.y = pk2(v[2], v[3]); *(u32x2*)(PA + (size_t)t * 512 + n0) = o; }
                    else { o.x = pk2(v[0], v[1]); o.y = pk2(v[2], v[3]); *(u32x2*)(PG + (size_t)t * 512 + n0) = o; } }
        }
        LAS bf16* SGm = AV;
        if (L > 0) {
#pragma unroll
            for (int nt = 0; nt < 4; ++nt) { const bf16x8 wf = *(const bf16x8*)(v2t + (size_t)(wave * 64 + nt * 16 + fr) * 32 + fq * 8); const int n0 = wave * 64 + nt * 16 + fq * 4; const f32x4 vb = *(const f32x4*)(v0 + n0);
#pragma unroll
                for (int m = 0; m < 4; ++m) { const bf16x8 af = lds_frag(VV, SVV, m * 16 + fr, fq * 8); const f32x4 av = __builtin_amdgcn_mfma_f32_16x16x32_bf16(wf, af, (f32x4){0.f, 0.f, 0.f, 0.f}, 0, 0, 0);
                    u32x2 o; o.x = pk2(sigmoidf_(vb[0] + av[0]), sigmoidf_(vb[1] + av[1])); o.y = pk2(sigmoidf_(vb[2] + av[2]), sigmoidf_(vb[3] + av[3]));
                    *(LAS u32x2*)(SGm + (m * 16 + fr) * SV + n0) = o; } }
            __syncthreads();
        }
#pragma unroll 2
        for (int it = 0; it < 8; ++it) { if (skip == 2) continue; const int idx = tid + 512 * it, tl = idx >> 6, c8 = (idx & 63) * 8; const int t = t0 + tl; const bool first = (t % SEQ) == 0;
#pragma unroll
            for (int which = 0; which < 3; ++which) { const bf16* zc = Zr + (size_t)t * NR + which * 512 + c8; const u32x4 c4 = *(const u32x4*)zc; u32x4 p4 = (u32x4){0u, 0u, 0u, 0u}; if (!first) p4 = *(const u32x4*)(zc - NR);
                const f32x4 m0 = *(const f32x4*)(mu + which * 512 + c8), m1 = *(const f32x4*)(mu + which * 512 + c8 + 4);
                float z[8]; const unsigned cw[4] = {c4.x, c4.y, c4.z, c4.w}, pw[4] = {p4.x, p4.y, p4.z, p4.w};
#pragma unroll
                for (int j = 0; j < 4; ++j) { const float c0 = bf_lo(cw[j]), c1 = bf_hi(cw[j]), p0 = bf_lo(pw[j]), p1 = bf_hi(pw[j]);
                    const float ma = (j < 2) ? m0[2 * j] : m1[2 * j - 4], mb = (j < 2) ? m0[2 * j + 1] : m1[2 * j - 3];
                    z[2 * j] = c0 + (p0 - c0) * ma; z[2 * j + 1] = c1 + (p1 - c1) * mb; }
                if (which == 2 && L > 0) { const u32x4 f4 = *(const u32x4*)(VF + (size_t)t * 512 + c8); const u32x4 s4 = *(const LAS u32x4*)(SGm + tl * SV + c8);
                    const unsigned fw[4] = {f4.x, f4.y, f4.z, f4.w}, sw[4] = {s4.x, s4.y, s4.z, s4.w};
#pragma unroll
                    for (int j = 0; j < 4; ++j) { z[2 * j] += (bf_lo(fw[j]) - z[2 * j]) * bf_lo(sw[j]); z[2 * j + 1] += (bf_hi(fw[j]) - z[2 * j + 1]) * bf_hi(sw[j]); } }
                u32x4 o; o.x = pk2(z[0], z[1]); o.y = pk2(z[2], z[3]); o.z = pk2(z[4], z[5]); o.w = pk2(z[6], z[7]);
                bf16* dst = (which == 0) ? PR : (which == 1) ? PK : PV; *(u32x4*)(dst + (size_t)t * 512 + c8) = o; } }
    }
}

__device__ __forceinline__ s16x4 vtr(const LAS bf16* p) { typedef short v4i16_t __attribute__((ext_vector_type(4))); return __builtin_bit_cast(s16x4, __builtin_amdgcn_ds_read_tr16_b64_v4i16((LAS v4i16_t*)p)); }
#ifndef MX_SWZ
#define MX_SWZ 1
#endif
constexpr int SM = MX_SWZ ? 64 : 72;
constexpr int SMA = 72;
__device__ __forceinline__ int MO(int row, int col) {
#if MX_SWZ
    return row * 64 + ((((col >> 3) ^ ((row & 3) | ((row & 8) >> 1))) << 3) | (col & 7));
#else
    return row * SM + col;
#endif
}
constexpr int MSZ = 64 * SM;
__device__ __forceinline__ bf16x8 frag_n(const LAS bf16* M, int idx0, int k0, int fr, int fq) { return *(const LAS bf16x8*)(M + MO(idx0 + fr, k0 + fq * 8)); }
__device__ __forceinline__ bf16x8 frag_t(const LAS bf16* M, int idx0, int k0, int fr, int fq) {
    const int r_ = k0 + 8 * fq + (fr >> 2), c_ = idx0 + 4 * (fr & 3);
    const u32x2 v0 = __builtin_bit_cast(u32x2, vtr(M + MO(r_, c_))), v1 = __builtin_bit_cast(u32x2, vtr(M + MO(r_ + 4, c_)));
    return __builtin_bit_cast(bf16x8, (u32x4){v0.x, v0.y, v1.x, v1.y});
}
template <bool FT, bool ST>
__device__ __forceinline__ f32x4 mm_tile(const LAS bf16* Fm, const LAS bf16* Sm_, int f0, int s0, f32x4 acc, int fr, int fq) {
#pragma unroll
    for (int ks = 0; ks < 2; ++ks) {
        const bf16x8 ff = FT ? frag_t(Fm, f0, ks * 32, fr, fq) : frag_n(Fm, f0, ks * 32, fr, fq);
        const bf16x8 sf = ST ? frag_t(Sm_, s0, ks * 32, fr, fq) : frag_n(Sm_, s0, ks * 32, fr, fq);
        acc = __builtin_amdgcn_mfma_f32_16x16x32_bf16(ff, sf, acc, 0, 0, 0);
    }
    return acc;
}
__device__ __forceinline__ void st_tile(LAS bf16* Z, int f0, int s0, f32x4 v, int fr, int fq) {
    u32x2 o; o.x = pk2(v[0], v[1]); o.y = pk2(v[2], v[3]); *(LAS u32x2*)(Z + MO(s0 + fr, f0 + 4 * fq)) = o;
}
__device__ __forceinline__ void st_tile_g(bf16* Z, int f0, int s0, f32x4 v, int fr, int fq) {
    u32x2 o; o.x = pk2(v[0], v[1]); o.y = pk2(v[2], v[3]); *(u32x2*)(Z + (size_t)(s0 + fr) * 512 + f0 + 4 * fq) = o;
}

constexpr int LT_SG = 136, LT_SV = 520, LT_SVV = 40;
constexpr int LT_AW = 119808, LT_AA = LT_AW + 9216, LT_AG = LT_AA + 9216, LT_VV = LT_AG + 17408;
static_assert(LT_VV + 5120 == LDSCTL_OFF, "LDS map");
__device__ __forceinline__ void local_tile_stage(ArgsP a, int L, int bc, LAS unsigned char* lds, int tid_in, int wave, int lane_in) {
    int tid = tid_in; asm volatile("" : "+v"(tid)); const int lane = tid & 63;
    unsigned char* ws = a->ws;
    const bf16* Zr = (const bf16*)(ws + WS_ZR); const bf16* v1t = (const bf16*)(ws + WS_TAB + TAB_V1T);
    const float* mu = a->in[I_MU] + (size_t)L * NR;
    const size_t tok0 = (size_t)bc * 64;
    LAS bf16* AV = (LAS bf16*)lds;
    LAS bf16* AW = (LAS bf16*)(lds + LT_AW); LAS bf16* AA = (LAS bf16*)(lds + LT_AA); LAS bf16* AG = (LAS bf16*)(lds + LT_AG); LAS bf16* VV = (LAS bf16*)(lds + LT_VV);
    const int fr = lane & 15, fq = lane >> 4;
    __syncthreads();
#pragma unroll
    for (int it = 0; it < 4; ++it) {
        const int idx = tid + 512 * it, tl = idx >> 5, c8 = idx & 31; const size_t t = tok0 + tl; const bool first = (t % SEQ) == 0;
        const bf16* zc = Zr + t * NR + 1536 + c8 * 8; const u32x4 c4 = *(const u32x4*)zc; u32x4 p4 = (u32x4){0u, 0u, 0u, 0u}; if (!first) p4 = *(const u32x4*)(zc - NR);
        const f32x4 m0 = *(const f32x4*)(mu + 1536 + c8 * 8), m1 = *(const f32x4*)(mu + 1536 + c8 * 8 + 4);
        float z[8]; const unsigned cw_[4] = {c4.x, c4.y, c4.z, c4.w}, pw_[4] = {p4.x, p4.y, p4.z, p4.w};
#pragma unroll
        for (int j = 0; j < 4; ++j) { const float c0 = bf_lo(cw_[j]), c1 = bf_hi(cw_[j]), p0 = bf_lo(pw_[j]), p1 = bf_hi(pw_[j]);
            const float ma = (j < 2) ? m0[2 * j] : m1[2 * j - 4], mb = (j < 2) ? m0[2 * j + 1] : m1[2 * j - 3];
            z[2 * j] = c0 + (p0 - c0) * ma; z[2 * j + 1] = c1 + (p1 - c1) * mb; }
        if (c8 < 8) {
#pragma unroll
            for (int j = 0; j < 8; ++j) { const float e = __expf(2.0f * z[j]); z[j] = 1.0f - 2.0f * __builtin_amdgcn_rcpf(e + 1.0f); }
        } else if (c8 >= 16) {
#pragma unroll
            for (int j = 0; j < 8; ++j) z[j] = __builtin_amdgcn_rcpf(1.0f + __expf(-z[j]));
        }
        u32x4 o; o.x = pk2(z[0], z[1]); o.y = pk2(z[2], z[3]); o.z = pk2(z[4], z[5]); o.w = pk2(z[6], z[7]);
        LAS bf16* dst = (c8 < 8) ? (AW + tl * SMA + c8 * 8) : (c8 < 16) ? (AA + tl * SMA + (c8 - 8) * 8) : (AG + tl * LT_SG + (c8 - 16) * 8);
        *(LAS u32x4*)dst = o;
    }
    if (L > 0) {
#pragma unroll
        for (int it = 0; it < 8; ++it) { const int idx = tid + 512 * it, tl = idx >> 6, c8 = idx & 63; const size_t t = tok0 + tl; const bool first = (t % SEQ) == 0;
            const bf16* zc = Zr + t * NR + 1024 + c8 * 8; const u32x4 c4 = *(const u32x4*)zc; u32x4 p4 = (u32x4){0u, 0u, 0u, 0u}; if (!first) p4 = *(const u32x4*)(zc - NR);
            const f32x4 m0 = *(const f32x4*)(mu + 1024 + c8 * 8), m1 = *(const f32x4*)(mu + 1024 + c8 * 8 + 4);
            float z[8]; const unsigned cw_[4] = {c4.x, c4.y, c4.z, c4.w}, pw_[4] = {p4.x, p4.y, p4.z, p4.w};
#pragma unroll
            for (int j = 0; j < 4; ++j) { const float c0 = bf_lo(cw_[j]), c1 = bf_hi(cw_[j]), p0 = bf_lo(pw_[j]), p1 = bf_hi(pw_[j]);
                const float ma = (j < 2) ? m0[2 * j] : m1[2 * j - 4], mb = (j < 2) ? m0[2 * j + 1] : m1[2 * j - 3];
                z[2 * j] = c0 + (p0 - c0) * ma; z[2 * j + 1] = c1 + (p1 - c1) * mb; }
            u32x4 o; o.x = pk2(z[0], z[1]); o.y = pk2(z[2], z[3]); o.z = pk2(z[4], z[5]); o.w = pk2(z[6], z[7]);
            *(LAS u32x4*)(AV + tl * LT_SV + c8 * 8) = o; }
        __syncthreads();
        const int m = wave & 3, nt2 = wave >> 2; f32x4 c = (f32x4){0.f, 0.f, 0.f, 0.f};
#pragma unroll
        for (int ks = 0; ks < 16; ++ks) { const bf16x8 wf = *(const bf16x8*)(v1t + (size_t)(nt2 * 16 + fr) * 512 + ks * 32 + fq * 8); const bf16x8 af = *(const LAS bf16x8*)(AV + (m * 16 + fr) * LT_SV + ks * 32 + fq * 8);
            c = __builtin_amdgcn_mfma_f32_16x16x32_bf16(wf, af, c, 0, 0, 0); }
        u32x2 o; o.x = pk2(c[0], c[1]); o.y = pk2(c[2], c[3]);
        *(LAS u32x2*)(VV + (m * 16 + fr) * LT_SVV + nt2 * 16 + fq * 4) = o;
    }
    __syncthreads();
}

struct HeadPF { u32x4 c4[3], p4[3], vf4; f32x4 mu[6]; bf16x8 w2f[2], a2f[2], g2f[4], v2f; f32x4 kkc[2], kac[2], rkc[2], wbc, abc, vbc; };
__device__ __forceinline__ void head_prefetch(ArgsP a, int L, int unit, int tid, int wave, HeadPF& pf) {
    const bf16* Zr = (const bf16*)(a->ws + WS_ZR); const bf16* VF = (const bf16*)(a->ws + WS_VF);
    const int h = unit & 7, bc = unit >> 3, tt = tid >> 3, jc = tid & 7; const size_t t = (size_t)bc * 64 + tt; const bool first = (t % SEQ) == 0;
    const bf16* zc = Zr + t * NR + h * 64 + jc * 8;
#pragma unroll
    for (int w3 = 0; w3 < 3; ++w3) { pf.c4[w3] = *(const u32x4*)(zc + w3 * 512); pf.p4[w3] = (u32x4){0u, 0u, 0u, 0u}; if (!first) pf.p4[w3] = *(const u32x4*)(zc + w3 * 512 - NR); }
    pf.vf4 = (u32x4){0u, 0u, 0u, 0u}; if (L > 0) pf.vf4 = *(const u32x4*)(VF + t * 512 + h * 64 + jc * 8);
    const float* mu = a->in[I_MU] + (size_t)L * NR + h * 64 + jc * 8;
#pragma unroll
    for (int w3 = 0; w3 < 3; ++w3) { pf.mu[2 * w3] = *(const f32x4*)(mu + w3 * 512); pf.mu[2 * w3 + 1] = *(const f32x4*)(mu + w3 * 512 + 4); }
    const bf16* w2t = (const bf16*)(a->ws + WS_TAB + TAB_W2T); const bf16* a2t = (const bf16*)(a->ws + WS_TAB + TAB_A2T); const bf16* g2t = (const bf16*)(a->ws + WS_TAB + TAB_G2T); const bf16* v2t = (const bf16*)(a->ws + WS_TAB + TAB_V2T);
    const int fr = tid & 15, fq = (tid & 63) >> 4; const size_t wrow = (size_t)(h * 64 + 16 * (wave & 3) + fr);
#pragma unroll
    for (int ks = 0; ks < 2; ++ks) { pf.w2f[ks] = *(const bf16x8*)(w2t + wrow * 64 + ks * 32 + fq * 8); pf.a2f[ks] = *(const bf16x8*)(a2t + wrow * 64 + ks * 32 + fq * 8); }
#pragma unroll
    for (int ks = 0; ks < 4; ++ks) pf.g2f[ks] = *(const bf16x8*)(g2t + wrow * 128 + ks * 32 + fq * 8);
    pf.v2f = (bf16x8){0, 0, 0, 0, 0, 0, 0, 0}; if (L > 0) pf.v2f = *(const bf16x8*)(v2t + wrow * 32 + fq * 8);
    const int ch0 = h * 64 + jc * 8, n0c = h * 64 + 16 * (wave & 3) + 4 * fq;
#pragma unroll
    for (int q = 0; q < 2; ++q) { pf.kkc[q] = *(const f32x4*)(a->in[I_KK] + L * 512 + ch0 + 4 * q); pf.kac[q] = *(const f32x4*)(a->in[I_KA] + L * 512 + ch0 + 4 * q); pf.rkc[q] = *(const f32x4*)(a->in[I_RK] + L * 512 + ch0 + 4 * q); }
    pf.wbc = *(const f32x4*)(a->in[I_W0] + L * 512 + n0c); pf.abc = *(const f32x4*)(a->in[I_A0] + L * 512 + n0c); pf.vbc = (f32x4){0.f, 0.f, 0.f, 0.f}; if (L > 0) pf.vbc = *(const f32x4*)(a->in[I_V0] + n0c);
}
__device__ __forceinline__ void local_head(ArgsP a, int L, int unit, int next_unit, HeadPF& pf, LAS unsigned char* lds, int tid_in, int wave, int lane_in) {
    int tid = tid_in; asm volatile("" : "+v"(tid)); const int lane = tid & 63;
    unsigned char* ws = a->ws;
    const bf16* Zr = (const bf16*)(ws + WS_ZR);
    bf16* PR = P_R(a); bf16* PK = P_K(a); bf16* PV = (bf16*)(ws + (L == 0 ? WS_VF : WS_PV)); bf16* PA = (bf16*)(ws + WS_PA); bf16* PL = (bf16*)(ws + WS_PL); bf16* PG = (bf16*)(ws + WS_PG);
    const bf16* VF = (const bf16*)(ws + WS_VF);
    float* WE = (float*)(ws + WS_WE); float* BSg = (float*)(ws + WS_BS);
    const bf16* w2t = (const bf16*)(ws + WS_TAB + TAB_W2T); const bf16* a2t = (const bf16*)(ws + WS_TAB + TAB_A2T); const bf16* g2t = (const bf16*)(ws + WS_TAB + TAB_G2T);
    const bf16* v2t = (const bf16*)(ws + WS_TAB + TAB_V2T);
    const float* mu = a->in[I_MU] + (size_t)L * NR;
    const int h = unit & 7, bc = unit >> 3;
    const size_t tok0 = (size_t)bc * 64; const size_t gbase = tok0 * 512 + h * 64;
    LAS bf16* Mx = (LAS bf16*)lds;
    LAS bf16* At = Mx + 0 * MSZ; LAS bf16* Rt = Mx + 1 * MSZ; LAS bf16* Bt = Mx + 2 * MSZ; LAS bf16* Kt = Mx + 3 * MSZ; LAS bf16* Vt = Mx + 4 * MSZ; LAS bf16* Bb = Mx + 5 * MSZ; LAS bf16* Kb = Mx + 6 * MSZ;
    LAS bf16* Nak = Mx + 7 * MSZ; LAS bf16* Mrb = Mx + 8 * MSZ; LAS bf16* Mrk = Mx + 9 * MSZ; LAS bf16* Na = Mx + 10 * MSZ; LAS bf16* Pa = Mx + 11 * MSZ; LAS bf16* NakV = Mx + 12 * MSZ;
    LAS bf16* Nb = Bt; LAS bf16* Pb = Kt; LAS bf16* Uv = Na; LAS bf16* Ah = Pb;
    const LAS bf16* AW = (const LAS bf16*)(lds + LT_AW); const LAS bf16* AA = (const LAS bf16*)(lds + LT_AA); const LAS bf16* AG = (const LAS bf16*)(lds + LT_AG); const LAS bf16* VV = (const LAS bf16*)(lds + LT_VV);
    constexpr int SG_ = LT_SG, SVV = LT_SVV;
    LAS float* CW = (LAS float*)(Mx + 7 * MSZ);
    LAS float* SEG = (LAS float*)(Mx + 9 * MSZ); LAS float* CW2 = (LAS float*)(Mx + 10 * MSZ);
    LAS bf16* ASt = Mx + 3 * MSZ;
    LAS bf16* SGt = Mx + 4 * MSZ;
    const int fr = lane & 15, fq = lane >> 4;
    const int tt = tid >> 3, jc = tid & 7, ch0 = h * 64 + jc * 8;
    const int s0 = (wave & 3) * 16, fbase = (wave >> 2) * 32;
    const f32x4 Z4 = (f32x4){0.f, 0.f, 0.f, 0.f};
    for (int rp5 = 0; rp5 < (LOCAL_REP == 5 ? 2 : 1); ++rp5) {
    float r[8], k[8], v[8];
    const u32x4 vf4 = pf.vf4;
    f32x4 kkc[2], kac[2], rkc[2];
    {
        u32x4 c4[3], p4[3];
#pragma unroll
        for (int w3 = 0; w3 < 3; ++w3) { c4[w3] = pf.c4[w3]; p4[w3] = pf.p4[w3]; }
#pragma unroll
        for (int w3 = 0; w3 < 3; ++w3) { const f32x4 m0 = pf.mu[2 * w3], m1 = pf.mu[2 * w3 + 1];
            const unsigned cw_[4] = {c4[w3].x, c4[w3].y, c4[w3].z, c4[w3].w}, pw_[4] = {p4[w3].x, p4[w3].y, p4[w3].z, p4[w3].w};
#pragma unroll
            for (int j = 0; j < 4; ++j) { const float c0 = bf_lo(cw_[j]), c1 = bf_hi(cw_[j]), p0 = bf_lo(pw_[j]), p1 = bf_hi(pw_[j]);
                const float ma = (j < 2) ? m0[2 * j] : m1[2 * j - 4], mb = (j < 2) ? m0[2 * j + 1] : m1[2 * j - 3];
                const float z0 = c0 + (p0 - c0) * ma, z1 = c1 + (p1 - c1) * mb;
                if (w3 == 0) { r[2 * j] = z0; r[2 * j + 1] = z1; } else if (w3 == 1) { k[2 * j] = z0; k[2 * j + 1] = z1; } else { v[2 * j] = z0; v[2 * j + 1] = z1; } } }
    }
    const bf16x8 w2f0 = pf.w2f[0], w2f1 = pf.w2f[1], a2f0 = pf.a2f[0], a2f1 = pf.a2f[1], g2f0 = pf.g2f[0], g2f1 = pf.g2f[1], g2f2 = pf.g2f[2], g2f3 = pf.g2f[3], v2f = pf.v2f;
    lds_barrier();
#pragma unroll
    for (int q = 0; q < 2; ++q) { kkc[q] = pf.kkc[q]; kac[q] = pf.kac[q]; rkc[q] = pf.rkc[q]; }
    const f32x4 wbc = pf.wbc, abc = pf.abc, vbc = pf.vbc;
#pragma unroll
    for (int q = 0; q < 2; ++q) { const int f0 = 16 * (wave & 3); const int trow = 32 * (wave >> 2) + 16 * q + fr;
        f32x4 cw_ = Z4, ca = Z4, cg = Z4;
        cw_ = __builtin_amdgcn_mfma_f32_16x16x32_bf16(w2f0, *(const LAS bf16x8*)(AW + trow * SMA + fq * 8), cw_, 0, 0, 0); cw_ = __builtin_amdgcn_mfma_f32_16x16x32_bf16(w2f1, *(const LAS bf16x8*)(AW + trow * SMA + 32 + fq * 8), cw_, 0, 0, 0);
        ca = __builtin_amdgcn_mfma_f32_16x16x32_bf16(a2f0, *(const LAS bf16x8*)(AA + trow * SMA + fq * 8), ca, 0, 0, 0); ca = __builtin_amdgcn_mfma_f32_16x16x32_bf16(a2f1, *(const LAS bf16x8*)(AA + trow * SMA + 32 + fq * 8), ca, 0, 0, 0);
        cg = __builtin_amdgcn_mfma_f32_16x16x32_bf16(g2f0, *(const LAS bf16x8*)(AG + trow * SG_ + fq * 8), cg, 0, 0, 0); cg = __builtin_amdgcn_mfma_f32_16x16x32_bf16(g2f1, *(const LAS bf16x8*)(AG + trow * SG_ + 32 + fq * 8), cg, 0, 0, 0);
        cg = __builtin_amdgcn_mfma_f32_16x16x32_bf16(g2f2, *(const LAS bf16x8*)(AG + trow * SG_ + 64 + fq * 8), cg, 0, 0, 0); cg = __builtin_amdgcn_mfma_f32_16x16x32_bf16(g2f3, *(const LAS bf16x8*)(AG + trow * SG_ + 96 + fq * 8), cg, 0, 0, 0);
        f32x4 ldv; u32x2 o;
#pragma unroll
        for (int j = 0; j < 4; ++j) { ldv[j] = -0.6065306597f * sigmoidf_(cw_[j] + wbc[j]); ca[j] = sigmoidf_(ca[j] + abc[j]); }
        *(LAS f32x4*)(CW + trow * 64 + f0 + 4 * fq) = ldv;
        o.x = pk2(ca[0], ca[1]); o.y = pk2(ca[2], ca[3]); *(LAS u32x2*)(ASt + MO(trow, f0 + 4 * fq)) = o;
        o.x = pk2(cg[0], cg[1]); o.y = pk2(cg[2], cg[3]); *(u32x2*)(PG + gbase + (size_t)trow * 512 + f0 + 4 * fq) = o;
        if (L > 0) {
            const f32x4 cv = __builtin_amdgcn_mfma_f32_16x16x32_bf16(v2f, *(const LAS bf16x8*)(VV + trow * SVV + fq * 8), Z4, 0, 0, 0);
            o.x = pk2(sigmoidf_(vbc[0] + cv[0]), sigmoidf_(vbc[1] + cv[1])); o.y = pk2(sigmoidf_(vbc[2] + cv[2]), sigmoidf_(vbc[3] + cv[3])); *(LAS u32x2*)(SGt + MO(trow, f0 + 4 * fq)) = o; }
    }
    lds_barrier();
    float as[8], ld[8];
    { const f32x4 l0 = *(const LAS f32x4*)(CW + tt * 64 + jc * 8), l1 = *(const LAS f32x4*)(CW + tt * 64 + jc * 8 + 4); const u32x4 a4 = *(const LAS u32x4*)(ASt + MO(tt, jc * 8));
      const unsigned aw[4] = {a4.x, a4.y, a4.z, a4.w};
#pragma unroll
      for (int j = 0; j < 4; ++j) { ld[j] = l0[j]; ld[4 + j] = l1[j]; as[2 * j] = bf_lo(aw[j]); as[2 * j + 1] = bf_hi(aw[j]); } }
    {   const int j = tid & 63, sg = tid >> 6; float run = 0.f;
#pragma unroll
        for (int q = 0; q < 8; ++q) { run += CW[(sg * 8 + q) * 64 + j]; CW2[(sg * 8 + q) * 64 + j] = run; }
        SEG[sg * 64 + j] = run; }
    if (L > 0) { const u32x4 s4 = *(const LAS u32x4*)(SGt + MO(tt, jc * 8)); const unsigned sw[4] = {s4.x, s4.y, s4.z, s4.w}, fw[4] = {vf4.x, vf4.y, vf4.z, vf4.w};
#pragma unroll
        for (int j = 0; j < 4; ++j) { v[2 * j] += (bf_lo(fw[j]) - v[2 * j]) * bf_lo(sw[j]); v[2 * j + 1] += (bf_hi(fw[j]) - v[2 * j + 1]) * bf_hi(sw[j]); } }
    { u32x4 v4; v4.x = pk2(v[0], v[1]); v4.y = pk2(v[2], v[3]); v4.z = pk2(v[4], v[5]); v4.w = pk2(v[6], v[7]);
      *(u32x4*)(PV + gbase + (size_t)tt * 512 + jc * 8) = v4;
      *(LAS u32x4*)(Vt + MO(tt, jc * 8)) = v4; }
    float kp[8], ap[8], bp[8];
    { float ss = 0.f, kx[8];
#pragma unroll
      for (int j = 0; j < 8; ++j) { kx[j] = k[j] * ((j < 4) ? kkc[0][j] : kkc[1][j - 4]); ss += kx[j] * kx[j]; }
      ss = red8(ss); const float inv = __builtin_amdgcn_rsqf(fmaxf(ss, 1e-24f)); float bsum = 0.f;
#pragma unroll
      for (int j = 0; j < 8; ++j) { const float kk = kx[j] * inv; ap[j] = -kk; bp[j] = kk * as[j]; kp[j] = k[j] * (1.0f + (as[j] - 1.0f) * ((j < 4) ? kac[0][j] : kac[1][j - 4])); bsum += r[j] * kp[j] * ((j < 4) ? rkc[0][j] : rkc[1][j - 4]); }
      bsum = red8(bsum);
      if (jc == 0) BSg[(tok0 + tt) * 8 + h] = bsum; }
    lds_barrier();
    float cw[8], cwe[8];
    {
        f32x4 o0 = Z4, o1 = Z4;
#pragma unroll 1
        for (int s2 = 0; s2 < wave; ++s2) { o0 = o0 + *(const LAS f32x4*)(SEG + s2 * 64 + jc * 8); o1 = o1 + *(const LAS f32x4*)(SEG + s2 * 64 + jc * 8 + 4); }
        f32x4 e0 = o0, e1 = o1;
#pragma unroll 1
        for (int s2 = wave; s2 < 8; ++s2) { e0 = e0 + *(const LAS f32x4*)(SEG + s2 * 64 + jc * 8); e1 = e1 + *(const LAS f32x4*)(SEG + s2 * 64 + jc * 8 + 4); }
        const f32x4 c0 = *(const LAS f32x4*)(CW2 + tt * 64 + jc * 8), c1 = *(const LAS f32x4*)(CW2 + tt * 64 + jc * 8 + 4);
#pragma unroll
        for (int j = 0; j < 4; ++j) { cw[j] = c0[j] + o0[j]; cw[4 + j] = c1[j] + o1[j]; cwe[j] = e0[j]; cwe[4 + j] = e1[j]; } }
    if (tt == 0) {
#pragma unroll
        for (int j = 0; j < 8; ++j) WE[(size_t)unit * 64 + jc * 8 + j] = __expf(cwe[j]);
    }
    { float oA[8], oR[8], oB[8], oK[8], oBb[8], oKb[8];
#pragma unroll
      for (int j = 0; j < 8; ++j) { const float ein = __expf(cw[j]), eneg = __expf(-cw[j]), eex = __expf(cw[j] - ld[j]), eend = __expf(cwe[j] - cw[j]);
          oA[j] = ap[j] * eex; oR[j] = r[j] * ein; oB[j] = bp[j] * eneg; oK[j] = kp[j] * eneg; oBb[j] = bp[j] * eend; oKb[j] = kp[j] * eend; }
#define ST8(M_, o_) do { u32x4 w_; w_.x = pk2(o_[0], o_[1]); w_.y = pk2(o_[2], o_[3]); w_.z = pk2(o_[4], o_[5]); w_.w = pk2(o_[6], o_[7]); *(LAS u32x4*)(M_ + MO(tt, jc * 8)) = w_; } while (0)
      ST8(At, oA); ST8(Rt, oR); ST8(Bt, oB); ST8(Kt, oK); ST8(Bb, oBb); ST8(Kb, oKb);
#undef ST8
    }
    lds_barrier();
    }
    f32x4 pacc[2];
    for (int rp = 0; rp < (LOCAL_REP == 2 ? 2 : 1); ++rp) { if (rp) lds_barrier();
#pragma unroll
    for (int q = 0; q < 2; ++q) { const int f0 = fbase + q * 16; const int tI = s0 + fr;
        f32x4 nab = mm_tile<false, false>(Bt, At, f0, s0, Z4, fr, fq), nak = mm_tile<false, false>(Kt, At, f0, s0, Z4, fr, fq);
        f32x4 mrb = mm_tile<false, false>(Bt, Rt, f0, s0, Z4, fr, fq), mrk = mm_tile<false, false>(Kt, Rt, f0, s0, Z4, fr, fq);
#pragma unroll
        for (int g = 0; g < 4; ++g) { const int sI = f0 + 4 * fq + g; if (!(sI < tI)) { nab[g] = 0.f; nak[g] = 0.f; } if (!(sI <= tI)) { mrb[g] = 0.f; mrk[g] = 0.f; } }
        pacc[q] = nab;
#pragma unroll
        for (int g = 0; g < 4; ++g) if (f0 + 4 * fq + g == tI) pacc[q][g] += 1.0f;
        st_tile(Nak, f0, s0, nak, fr, fq); st_tile(Mrb, f0, s0, mrb, fr, fq); st_tile(Mrk, f0, s0, mrk, fr, fq); st_tile(Na, f0, s0, nab, fr, fq); st_tile(Pa, f0, s0, pacc[q], fr, fq); } }
    lds_barrier();
    if (next_unit >= 0) head_prefetch(a, L, next_unit, tid, wave, pf);
    const int dblk = wave >> 2, bk0 = 32 * dblk, bf0 = bk0 + 16 * (wave & 1), bs0 = bk0 + 16 * ((wave >> 1) & 1);
#define MMK(Fm_, ft_, Sm_, st_, f0_, s0_, k0_, acc_) __builtin_amdgcn_mfma_f32_16x16x32_bf16((ft_) ? frag_t(Fm_, f0_, k0_, fr, fq) : frag_n(Fm_, f0_, k0_, fr, fq), (st_) ? frag_t(Sm_, s0_, k0_, fr, fq) : frag_n(Sm_, s0_, k0_, fr, fq), acc_, 0, 0, 0)
    f32x4 pblk;
    { const u32x2 pp = *(const LAS u32x2*)(Pa + MO(bs0 + fr, bf0 + 4 * fq)); pblk = (f32x4){bf_lo(pp.x), bf_hi(pp.x), bf_lo(pp.y), bf_hi(pp.y)}; }
    st_tile(Nb, bf0, bs0, MMK(Na, true, Na, false, bf0, bs0, bk0, Z4), fr, fq);
#pragma unroll
    for (int q = 0; q < 2; ++q) { const int f0 = fbase + q * 16; st_tile(NakV, f0, s0, mm_tile<true, false>(Vt, Nak, f0, s0, Z4, fr, fq), fr, fq); }
    lds_barrier();
    {
        LAS bf16* Ncur = Nb; LAS bf16* Nnext = Na; LAS bf16* Pcur = Pa; LAS bf16* Pnext = Pb;
#pragma unroll 1
        for (int it = 1; it <= 4; ++it) {
            const bf16x8 nf = frag_t(Ncur, bf0, bk0, fr, fq);
            pblk = __builtin_amdgcn_mfma_f32_16x16x32_bf16(nf, frag_n(Pcur, bs0, bk0, fr, fq), pblk, 0, 0, 0);
            st_tile(Pnext, bf0, bs0, pblk, fr, fq);
            if (it < 4) st_tile(Nnext, bf0, bs0, __builtin_amdgcn_mfma_f32_16x16x32_bf16(nf, frag_n(Ncur, bs0, bk0, fr, fq), Z4, 0, 0, 0), fr, fq);
            lds_barrier();
            LAS bf16* tN = Ncur; Ncur = Nnext; Nnext = tN; LAS bf16* tP = Pcur; Pcur = Pnext; Pnext = tP;
        }
    }
    if (wave < 4) { const int mf0 = 16 * (wave & 1), ms0 = 32 + 16 * (wave >> 1); st_tile(Pb, mf0, ms0, MMK(Pa, true, Na, false, mf0, ms0, 0, Z4), fr, fq); }
    lds_barrier();
    if (wave < 4) { const int mf0 = 16 * (wave & 1), ms0 = 32 + 16 * (wave >> 1); st_tile(Pa, mf0, ms0, MMK(Pb, true, Pa, false, mf0, ms0, 32, Z4), fr, fq); }
    lds_barrier();
#undef MMK
#pragma unroll
    for (int q = 0; q < 2; ++q) { const int f0 = fbase + q * 16;
        st_tile(Uv, f0, s0, mm_tile<true, false>(NakV, Pa, f0, s0, Z4, fr, fq), fr, fq);
        st_tile(Ah, f0, s0, mm_tile<true, false>(At, Pa, f0, s0, Z4, fr, fq), fr, fq); }
    lds_barrier();
    for (int rp = 0; rp < (LOCAL_REP == 3 ? 2 : 1); ++rp)
#pragma unroll
    for (int q = 0; q < 2; ++q) { const int f0 = fbase + q * 16;
        {
            const u32x2 rr = *(const LAS u32x2*)(Rt + MO(s0 + fr, f0 + 4 * fq)); const f32x4 r0 = (f32x4){bf_lo(rr.x), bf_hi(rr.x), bf_lo(rr.y), bf_hi(rr.y)};
            st_tile_g(PR + gbase, f0, s0, mm_tile<true, false>(Ah, Mrb, f0, s0, r0, fr, fq), fr, fq); }
        {
            f32x4 y = mm_tile<true, false>(Uv, Mrb, f0, s0, Z4, fr, fq); y = mm_tile<true, false>(Vt, Mrk, f0, s0, y, fr, fq); st_tile_g(PK + gbase, f0, s0, y, fr, fq); }
        {
            st_tile_g(PA + gbase, f0, s0, mm_tile<true, true>(Ah, Bb, f0, s0, Z4, fr, fq), fr, fq); }
        {
            f32x4 hh = mm_tile<true, true>(Bb, Uv, f0, s0, Z4, fr, fq); hh = mm_tile<true, true>(Kb, Vt, f0, s0, hh, fr, fq); st_tile_g(PL + gbase, f0, s0, hh, fr, fq); }
    }
}

__device__ __forceinline__ void chain_sequence(ArgsP a, int L, int seq, LAS unsigned char* lds, int tid, int wave, int lane) {
    unsigned char* ws = a->ws;
    const bf16* PR = P_R(a); const bf16* PK = P_K(a); const bf16* PV = (const bf16*)(ws + (L == 0 ? WS_VF : WS_PV)); const bf16* PA = (const bf16*)(ws + WS_PA);
    const bf16* PG = (const bf16*)(ws + WS_PG); const bf16* PL = (const bf16*)(ws + WS_PL); bf16* YC = (bf16*)(ws + WS_YC);
    const float* WE = (const float*)(ws + WS_WE); const float* BSg = (const float*)(ws + WS_BS);
    const int b = seq >> 3, h = seq & 7;
    LAS bf16* Mx = (LAS bf16*)lds;
    LAS bf16* Sb = Mx;
    LAS float* Yf = (LAS float*)(Mx + 9 * MSZ);
    LAS float* Wl = Yf + 64 * 68;
    const int fr = lane & 15, fq = lane >> 4, tt = tid >> 3, jc = tid & 7, ch0 = h * 64 + jc * 8;
    const int s0 = (wave & 3) * 16, fbase = (wave >> 2) * 32;
    float lnw[8], lnb[8];
#pragma unroll
    for (int j = 0; j < 8; ++j) { lnw[j] = a->in[I_LNW][L * 512 + ch0 + j]; lnb[j] = a->in[I_LNB][L * 512 + ch0 + j]; }
    f32x4 sreg[2] = {(f32x4){0.f, 0.f, 0.f, 0.f}, (f32x4){0.f, 0.f, 0.f, 0.f}};
    const size_t row0 = (size_t)b * SEQ;
    __syncthreads();
    *(LAS u32x4*)(Sb + MO(tt, jc * 8)) = (u32x4){0u, 0u, 0u, 0u};
    {
        const size_t off = (row0 + tt) * 512 + ch0;
        *(LAS u32x4*)(Mx + 1 * MSZ + MO(tt, jc * 8)) = *(const u32x4*)(PA + off); *(LAS u32x4*)(Mx + 2 * MSZ + MO(tt, jc * 8)) = *(const u32x4*)(PL + off);
        *(LAS u32x4*)(Mx + 3 * MSZ + MO(tt, jc * 8)) = *(const u32x4*)(PR + off); *(LAS u32x4*)(Mx + 4 * MSZ + MO(tt, jc * 8)) = *(const u32x4*)(PK + off);
        if (tid < 64) Wl[tid] = WE[((size_t)(b * 32) * 8 + h) * 64 + tid];
    }
    struct ChT { u32x4 g, h, r, y; float wl; }; struct ChQ { u32x4 v, gg; float bon; };
    ChT T4[4]; ChQ Q4[4];
#define CH_LOADT(T_, cs_) do { const size_t off_ = (row0 + (size_t)(cs_) * 64 + tt) * 512 + ch0; T_.g = *(const u32x4*)(PA + off_); T_.h = *(const u32x4*)(PL + off_); T_.r = *(const u32x4*)(PR + off_); T_.y = *(const u32x4*)(PK + off_); \
        T_.wl = (tid < 64) ? WE[((size_t)(b * 32 + (cs_)) * 8 + h) * 64 + tid] : 0.f; } while (0)
#define CH_LOADQ(Q_, cs_) do { const size_t off_ = (row0 + (size_t)(cs_) * 64 + tt) * 512 + ch0; Q_.v = *(const u32x4*)(PV + off_); Q_.gg = *(const u32x4*)(PG + off_); Q_.bon = BSg[(row0 + (size_t)(cs_) * 64 + tt) * 8 + h]; } while (0)
#pragma unroll
    for (int u = 0; u < 4; ++u) { CH_LOADT(T4[u], u + 1); CH_LOADQ(Q4[u], u); }
#pragma unroll 1
    for (int c0 = 0; c0 < 32; c0 += 4) {
#pragma unroll
      for (int u = 0; u < 4; ++u) {
        const int c = c0 + u; const int p = u & 1;
        const LAS bf16* Gl = Mx + (1 + 4 * p) * MSZ; const LAS bf16* Ht = Gl + MSZ; const LAS bf16* Rh = Ht + MSZ; const LAS bf16* Yl = Rh + MSZ;
        __syncthreads();
        f32x4 sn[2];
#pragma unroll
        for (int q = 0; q < 2; ++q) { const int f0 = fbase + q * 16;
            {
                const u32x2 yy = *(const LAS u32x2*)(Yl + MO(s0 + fr, f0 + 4 * fq)); const f32x4 y0 = (f32x4){bf_lo(yy.x), bf_hi(yy.x), bf_lo(yy.y), bf_hi(yy.y)};
                const f32x4 y = mm_tile<false, false>(Sb, Rh, f0, s0, y0, fr, fq);
                *(LAS f32x4*)(Yf + (s0 + fr) * 68 + f0 + 4 * fq) = y; }
            {
                const u32x2 hh = *(const LAS u32x2*)(Ht + MO(s0 + fr, f0 + 4 * fq)); const f32x4 wv = *(const LAS f32x4*)(Wl + p * 64 + f0 + 4 * fq);
                f32x4 c0v = (f32x4){bf_lo(hh.x), bf_hi(hh.x), bf_lo(hh.y), bf_hi(hh.y)};
                c0v = c0v + sreg[q] * wv;
                sn[q] = mm_tile<false, false>(Gl, Sb, f0, s0, c0v, fr, fq); }
        }
        __syncthreads();
#pragma unroll
        for (int q = 0; q < 2; ++q) { sreg[q] = sn[q]; st_tile(Sb, fbase + q * 16, s0, sn[q], fr, fq); }
        if (c + 1 < 32) {
            LAS bf16* Gn = Mx + (1 + 4 * (p ^ 1)) * MSZ;
            *(LAS u32x4*)(Gn + MO(tt, jc * 8)) = T4[u].g; *(LAS u32x4*)(Gn + MSZ + MO(tt, jc * 8)) = T4[u].h; *(LAS u32x4*)(Gn + 2 * MSZ + MO(tt, jc * 8)) = T4[u].r; *(LAS u32x4*)(Gn + 3 * MSZ + MO(tt, jc * 8)) = T4[u].y;
            if (tid < 64) Wl[(p ^ 1) * 64 + tid] = T4[u].wl;
            if (c + 5 < 32) CH_LOADT(T4[u], c + 5);
        }
        {
            const u32x4 v4 = Q4[u].v, gg4 = Q4[u].gg; const float bon = Q4[u].bon;
            float y[8], s1 = 0.f;
            const f32x4 ya = *(const LAS f32x4*)(Yf + tt * 68 + jc * 8), yb = *(const LAS f32x4*)(Yf + tt * 68 + jc * 8 + 4);
#pragma unroll
            for (int j = 0; j < 4; ++j) { y[j] = ya[j]; y[4 + j] = yb[j]; }
#pragma unroll
            for (int j = 0; j < 8; ++j) s1 += y[j];
            const float mean = red8(s1) * (1.0f / 64.0f); float s2 = 0.f;
#pragma unroll
            for (int j = 0; j < 8; ++j) { y[j] -= mean; s2 += y[j] * y[j]; }
            const float rstd = __builtin_amdgcn_rsqf(red8(s2) * (1.0f / 64.0f) + GN_EPS);
            const unsigned vw[4] = {v4.x, v4.y, v4.z, v4.w}, gw_[4] = {gg4.x, gg4.y, gg4.z, gg4.w};
            float o[8];
#pragma unroll
            for (int j = 0; j < 4; ++j) { o[2 * j] = (y[2 * j] * rstd * lnw[2 * j] + lnb[2 * j] + bon * bf_lo(vw[j])) * bf_lo(gw_[j]); o[2 * j + 1] = (y[2 * j + 1] * rstd * lnw[2 * j + 1] + lnb[2 * j + 1] + bon * bf_hi(vw[j])) * bf_hi(gw_[j]); }
            u32x4 w; w.x = pk2(o[0], o[1]); w.y = pk2(o[2], o[3]); w.z = pk2(o[4], o[5]); w.w = pk2(o[6], o[7]);
            *(u32x4*)(YC + (row0 + c * 64 + tt) * D + ch0) = w;
        }
        if (c + 4 < 32) CH_LOADQ(Q4[u], c + 4);
      }
    }
#undef CH_LOADT
#undef CH_LOADQ
    __syncthreads();
}

__device__ __forceinline__ void attn_phase(ArgsP a, int L, int rep, LAS unsigned char* lds, int tid, int wave, int lane) {
    unsigned char* ws = a->ws;
    const bf16* Za = (const bf16*)(ws + WS_ZA); bf16* YC = (bf16*)(ws + WS_YC);
    unsigned* ctl = (unsigned*)(ws + WS_CTL);
    volatile LAS int* qs = (volatile LAS int*)(lds + LDSCTL_OFF + LC_Q);
    constexpr int TILE_B = 65536;
    LAS float* Bt = (LAS float*)(lds + 2 * TILE_B);
    const int hl = wave >> 1, qh = wave & 1, fr = lane & 15, fq = lane >> 4;
    constexpr float LOG2E = 1.4426950408889634f;
    const int myq = (int)(xb_xcc_id() & 7u);
    __syncthreads();
    for (int i = tid; i < 5120; i += 512) { const int hh = i / 640, x = i - hh * 640; int rel = 575 - x; rel = rel > 256 ? 256 : rel; rel = rel < -63 ? -63 : rel; Bt[i] = a->in[I_RELB][((size_t)L * 8 + hh) * 320 + rel + 63] * LOG2E; }
    const unsigned lds0 = (unsigned)(uintptr_t)lds;
    const unsigned wdst = (unsigned)((wave >> 2) * 32768 + (wave & 3) * 8192);
    const size_t dlane = (size_t)(lane >> 3) * NA + (wave < 4 ? 512 : 1024) + (wave & 3) * 64 + (((lane & 7) ^ (lane >> 3)) * 8);
#define ATT_DMA(bufsel_, src_) do { _Pragma("unroll") for (int _i = 0; _i < 8; ++_i) { unsigned keep_; const unsigned dst_ = (unsigned)__builtin_amdgcn_readfirstlane((int)(lds0 + (unsigned)((bufsel_) * TILE_B) + wdst + (unsigned)(_i * 1024))); \
        asm volatile("s_mov_b32 %0, m0\n\ts_mov_b32 m0, %2\n\ts_nop 0\n\tglobal_load_lds_dwordx4 %1, off\n\ts_mov_b32 m0, %0" : "=&s"(keep_) : "v"((src_) + (size_t)_i * 8 * NA), "s"(dst_) : "memory"); } } while (0)
#define ATT_QADDR(qi_) (ctl + CW_QUEUE + ((L * 2 + rep) * 8 + ((myq + (qi_)) & 7)) * 64)
#define ATT_ITEM(qi_, j_) ((((((myq + (qi_)) & 7) * 4 + ((j_) & 3)) >> 1) * 64) + ((j_) >> 2) * 2 + (((((myq + (qi_)) & 7) * 4 + ((j_) & 3))) & 1))
#define ATT_SRC0(item_) (Za + ((size_t)((item_) >> 6) * SEQ + (size_t)((((item_) >> 1) & 31) - 8 + (((((item_) >> 1) & 31) < 8) ? 8 - (((item_) >> 1) & 31) : 0)) * 64) * NA + ((item_) & 1) * 256 + dlane)
#define ATT_LOADQ(dst_, item_) do { const size_t tq_ = (size_t)((item_) >> 6) * SEQ + (((item_) >> 1) & 31) * 64 + qh * 32 + fr; _Pragma("unroll") for (int m = 0; m < 2; ++m) _Pragma("unroll") for (int ks = 0; ks < 2; ++ks) \
        dst_[m][ks] = *(const bf16x8*)(Za + (tq_ + m * 16) * NA + (4 * ((item_) & 1) + hl) * 64 + ks * 32 + fq * 8); } while (0)
    int qi = 0, cur = -1;
#define ATT_SYNC_POP(dst_) do { dst_ = -1; while (qi < 8) { __syncthreads(); if (tid == 0) qs[0] = (int)atomicAdd(ATT_QADDR(qi), 1u); __syncthreads(); const int j_ = qs[0]; if (j_ >= 128) { ++qi; continue; } dst_ = ATT_ITEM(qi, j_); break; } } while (0)
    ATT_SYNC_POP(cur);
    bool pre = false; int pb = 0;
    bf16x8 qf[2][2];
    const int x7 = fr & 7;
    const int vr7 = (fq & 1) * 4 + (fr >> 2);
    while (cur >= 0) {
        const int b = cur >> 6, c = (cur >> 1) & 31, hq = cur & 1, head = 4 * hq + hl;
        const int jb0 = (c < 8 ? 8 - c : 0);
        const bf16* dsrc = ATT_SRC0(cur);
        if (!pre) { ATT_DMA(pb, dsrc); ATT_LOADQ(qf, cur); }
        unsigned jn = 0u;
        if (jb0 == 8) { if (tid == 0) jn = atomicAdd(ATT_QADDR(qi), 1u); }
#pragma unroll
        for (int m = 0; m < 2; ++m)
#pragma unroll
            for (int ks = 0; ks < 2; ++ks) asm volatile("" :: "v"(qf[m][ks]));
        const size_t tq0 = (size_t)b * SEQ + c * 64 + qh * 32 + fr;
        f32x4 oacc[2][4];
#pragma unroll
        for (int m = 0; m < 2; ++m)
#pragma unroll
            for (int d = 0; d < 4; ++d) oacc[m][d] = (f32x4){0.f, 0.f, 0.f, 0.f};
        float mrun[2] = {-1e30f, -1e30f}, lrun[2] = {0.f, 0.f};
        const LAS float* bh = Bt + (hq * 4 + hl) * 640;
        int nxt = -1; bf16x8 qfn[2][2];
#pragma unroll
        for (int m = 0; m < 2; ++m)
#pragma unroll
            for (int ks = 0; ks < 2; ++ks) qfn[m][ks] = qf[m][ks];
        for (int jb = jb0; jb <= 8; ++jb, pb ^= 1) {
            if (jb == 8 && tid == 0) qs[0] = (int)jn;
            asm volatile("s_waitcnt vmcnt(0) lgkmcnt(0)" ::: "memory");
            __builtin_amdgcn_s_barrier(); asm volatile("" ::: "memory");
            if (jb < 8) { dsrc += (size_t)64 * NA; ATT_DMA(pb ^ 1, dsrc);
                if (jb == jb0) { if (tid == 0) jn = atomicAdd(ATT_QADDR(qi), 1u); } }
            else { const int j_ = qs[0];
                if (j_ < 128) { nxt = ATT_ITEM(qi, j_); const bf16* nsrc = ATT_SRC0(nxt); ATT_DMA(pb ^ 1, nsrc); ATT_LOADQ(qfn, nxt); } else nxt = -2; }
            const LAS bf16* Kh = (const LAS bf16*)(lds + pb * TILE_B) + hl * 4096; const LAS bf16* Vh = Kh + 16384;
            f32x4 sacc[2][4];
#pragma unroll
            for (int kt = 0; kt < 4; ++kt) {
                const LAS bf16* kp = Kh + (kt * 16 + fr) * 64;
                const bf16x8 kf0 = *(const LAS bf16x8*)(kp + ((fq ^ x7) * 8)), kf1 = *(const LAS bf16x8*)(kp + (((4 + fq) ^ x7) * 8));
#pragma unroll
                for (int m = 0; m < 2; ++m) { f32x4 z = (f32x4){0.f, 0.f, 0.f, 0.f}; z = __builtin_amdgcn_mfma_f32_16x16x32_bf16(kf0, qf[m][0], z, 0, 0, 0); sacc[m][kt] = __builtin_amdgcn_mfma_f32_16x16x32_bf16(kf1, qf[m][1], z, 0, 0, 0); } }
            const float bconst = bh[0];
#pragma unroll
            for (int m = 0; m < 2; ++m) {
                const int qi_ = qh * 32 + m * 16 + fr;
                float tmax = -1e30f;
                if (jb <= 3) {
#pragma unroll
                    for (int kt = 0; kt < 4; ++kt)
#pragma unroll
                        for (int j = 0; j < 4; ++j) { const float sv = sacc[m][kt][j] * (0.125f * LOG2E) + bconst; sacc[m][kt][j] = sv; tmax = fmaxf(tmax, sv); }
                } else {
                    const LAS float* bp_ = bh + (63 - qi_) + jb * 64 + fq * 4;
#pragma unroll
                    for (int kt = 0; kt < 4; ++kt)
#pragma unroll
                        for (int j = 0; j < 4; ++j) { const float sv = sacc[m][kt][j] * (0.125f * LOG2E) + bp_[kt * 16 + j]; sacc[m][kt][j] = sv; tmax = fmaxf(tmax, sv); }
                }
                tmax = fmaxf(tmax, __shfl_xor(tmax, 16)); tmax = fmaxf(tmax, __shfl_xor(tmax, 32));
                const float mnew = fmaxf(mrun[m], tmax), alpha = __builtin_amdgcn_exp2f(mrun[m] - mnew); mrun[m] = mnew;
                float psum = 0.f;
#pragma unroll
                for (int kt = 0; kt < 4; ++kt)
#pragma unroll
                    for (int j = 0; j < 4; ++j) { const float p = __builtin_amdgcn_exp2f(sacc[m][kt][j] - mnew); sacc[m][kt][j] = p; psum += p; }
                lrun[m] = lrun[m] * alpha + psum;
#pragma unroll
                for (int d = 0; d < 4; ++d) oacc[m][d] = oacc[m][d] * alpha;
            }
#pragma unroll
            for (int s2 = 0; s2 < 2; ++s2) {
                bf16x8 pf[2];
#pragma unroll
                for (int m = 0; m < 2; ++m) { u32x4 pw; pw.x = pg8::cvt_pk_bf16(sacc[m][2 * s2][0], sacc[m][2 * s2][1]); pw.y = pg8::cvt_pk_bf16(sacc[m][2 * s2][2], sacc[m][2 * s2][3]); pw.z = pg8::cvt_pk_bf16(sacc[m][2 * s2 + 1][0], sacc[m][2 * s2 + 1][1]); pw.w = pg8::cvt_pk_bf16(sacc[m][2 * s2 + 1][2], sacc[m][2 * s2 + 1][3]);
                    pf[m] = __builtin_bit_cast(bf16x8, pw); }
                const LAS bf16* vp = Vh + (s2 * 32 + fq * 4 + (fr >> 2)) * 64 + 4 * (fr & 1);
#pragma unroll
                for (int d = 0; d < 4; ++d) {
                    const int vc = ((d * 2 + ((fr & 3) >> 1)) ^ vr7) * 8;
                    const u32x2 v0 = __builtin_bit_cast(u32x2, vtr(vp + vc));
                    const u32x2 v1 = __builtin_bit_cast(u32x2, vtr(vp + 16 * 64 + vc));
                    const bf16x8 vf = __builtin_bit_cast(bf16x8, (u32x4){v0.x, v0.y, v1.x, v1.y});
#pragma unroll
                    for (int m = 0; m < 2; ++m) oacc[m][d] = __builtin_amdgcn_mfma_f32_16x16x32_bf16(vf, pf[m], oacc[m][d], 0, 0, 0);
                }
            }
        }
#pragma unroll
        for (int m = 0; m < 2; ++m) {
            float l = lrun[m]; l += __shfl_xor(l, 16); l += __shfl_xor(l, 32);
            const float inv = 1.0f / l;
#pragma unroll
            for (int d = 0; d < 4; ++d) { u32x2 o; o.x = pk2(oacc[m][d][0] * inv, oacc[m][d][1] * inv); o.y = pk2(oacc[m][d][2] * inv, oacc[m][d][3] * inv);
                *(u32x2*)(YC + (tq0 + m * 16) * D + 512 + head * 64 + d * 16 + fq * 4) = o; }
        }
        if (nxt == -2) { ++qi; ATT_SYNC_POP(nxt); pre = false; }
        else { pre = true;
#pragma unroll
            for (int m = 0; m < 2; ++m)
#pragma unroll
                for (int ks = 0; ks < 2; ++ks) qf[m][ks] = qfn[m][ks]; }
        cur = nxt;
    }
    asm volatile("s_waitcnt vmcnt(0)" ::: "memory");
    __syncthreads();
#undef ATT_DMA
#undef ATT_QADDR
#undef ATT_ITEM
#undef ATT_SRC0
#undef ATT_LOADQ
#undef ATT_SYNC_POP
}

__device__ __forceinline__ void phase_router(ArgsP a, int L, LAS unsigned char* lds, int gw, int NGW, int wave, int lane, int rep) {
    unsigned char* ws = a->ws;
    const bf16* h = H_CUR(a, L); float* RSTD = (float*)(ws + WS_RSTD);
    const bf16* WRH = (const bf16*)(ws + WS_TAB + TAB_WRH); const bf16* WRL = (const bf16*)(ws + WS_TAB + TAB_WRL);
    int* perm = (int*)(ws + WS_PERM); float* srs = (float*)(ws + WS_SRS); float* scw = (float*)(ws + WS_SCW); int* tokslot = (int*)(ws + WS_TOKSLOT);
    unsigned* cnt = (unsigned*)(ws + WS_CTL) + CW_CNT + (L * 2 + rep) * 2048;
    LAS float* lg = (LAS float*)(lds + wave * 4096);
    LAS float* lbias = (LAS float*)(lds + 32768);
    LAS unsigned* lcnt = (LAS unsigned*)(lds + 32768 + 256); LAS unsigned* lbase = lcnt + 32;
    constexpr int SBK = 264; LAS bf16* Bs = (LAS bf16*)(lds + 40960);
    const int fr = lane & 15, fq = lane >> 4, tid = wave * 64 + lane;
    if (tid < 4) lbias[tid] = a->in[I_RGB][L * 4 + tid]; else if (tid < 36) lbias[tid] = a->in[I_REB][L * 32 + tid - 4];
    const int ntrip = (T / 16 + NGW - 1) / NGW;
    for (int trip = 0; trip < ntrip; ++trip) {
        const int rt = trip * NGW + gw; const bool live = rt < T / 16;
        if (tid < 32) lcnt[tid] = 0u;
        __syncthreads();
        int e1 = 0, e2 = 0; unsigned lp1 = 0u, lp2 = 0u; float rstd = 0.f, c1 = 0.f, c2 = 0.f; const int row = rt * 16 + fr;
        f32x4 acc[3]; acc[0] = acc[1] = acc[2] = (f32x4){0.f, 0.f, 0.f, 0.f};
        float ssq = 0.f;
        {
            const bf16* hr = h + (size_t)(live ? row : 0) * D + 8 * fq;
            u32x4 breg[6];
#define RT_LOADB(kc_) do { _Pragma("unroll") for (int i = 0; i < 6; ++i) { const int idx = tid + 512 * i, arr = idx / 1536, rem = idx - arr * 1536, r_ = rem >> 5, c_ = rem & 31; \
                breg[i] = *(const u32x4*)((arr ? WRL : WRH) + (size_t)r_ * D + (kc_) * 256 + c_ * 8); } } while (0)
            RT_LOADB(0);
#pragma unroll 1
            for (int kc = 0; kc < 4; ++kc) {
                __syncthreads();
#pragma unroll
                for (int i = 0; i < 6; ++i) { const int idx = tid + 512 * i, arr = idx / 1536, rem = idx - arr * 1536, r_ = rem >> 5, c_ = rem & 31; *(LAS u32x4*)(Bs + (arr * 48 + r_) * SBK + c_ * 8) = breg[i]; }
                __syncthreads();
                if (kc < 3) RT_LOADB(kc + 1);
#pragma unroll
                for (int ks = 0; ks < 8; ++ks) {
                    const u32x4 hv = *(const u32x4*)(hr + kc * 256 + 32 * ks); const unsigned hw[4] = {hv.x, hv.y, hv.z, hv.w};
#pragma unroll
                    for (int j = 0; j < 4; ++j) { const float p = bf_lo(hw[j]), q = bf_hi(hw[j]); ssq += p * p + q * q; }
                    const bf16x8 ah = __builtin_bit_cast(bf16x8, hv);
#pragma unroll
                    for (int nt = 0; nt < 3; ++nt) { const LAS bf16* bp_ = Bs + (nt * 16 + fr) * SBK + 32 * ks + 8 * fq; const bf16x8 bh = *(const LAS bf16x8*)bp_, bl = *(const LAS bf16x8*)(bp_ + 48 * SBK);
                        acc[nt] = __builtin_amdgcn_mfma_f32_16x16x32_bf16(bh, ah, acc[nt], 0, 0, 0); acc[nt] = __builtin_amdgcn_mfma_f32_16x16x32_bf16(bl, ah, acc[nt], 0, 0, 0); }
                }
            }
#undef RT_LOADB
        }
        if (live) {
        ssq += __shfl_xor(ssq, 16); ssq += __shfl_xor(ssq, 32);
        rstd = 1.0f / sqrtf(ssq * (1.0f / D) + RMS_EPS);
        if (fq == 0) RSTD[row] = rstd;
#pragma unroll
        for (int nt = 0; nt < 3; ++nt) *(LAS f32x4*)(lg + fr * 52 + nt * 16 + 4 * fq) = acc[nt];
        asm volatile("s_waitcnt lgkmcnt(0)" ::: "memory");
        if (fq == 0) {
            const LAS float* lr = lg + fr * 52;
            float gl[4]; float gmax = -1e30f; int gsel = 0;
#pragma unroll
            for (int j = 0; j < 4; ++j) { gl[j] = lr[j] * rstd + lbias[j]; if (gl[j] > gmax) { gmax = gl[j]; gsel = j; } }
            float gs = 0.f;
#pragma unroll
            for (int j = 0; j < 4; ++j) gs += __expf(gl[j] - gmax);
            const float pg = 1.0f / gs;
            float l1 = -1e30f, l2 = -1e30f; int i1 = 0, i2 = 0;
#pragma unroll
            for (int j = 0; j < 8; ++j) { const float v = lr[4 + gsel * 8 + j] * rstd + lbias[4 + gsel * 8 + j];
                const bool gt1 = v > l1, gt2 = v > l2;
                l2 = gt1 ? l1 : (gt2 ? v : l2); i2 = gt1 ? i1 : (gt2 ? j : i2); l1 = gt1 ? v : l1; i1 = gt1 ? j : i1; }
            const float w1 = 1.0f / (1.0f + __expf(l2 - l1));
            e1 = gsel * 8 + i1; e2 = gsel * 8 + i2; c1 = pg * w1; c2 = pg * (1.0f - w1);
            lp1 = atomicAdd((unsigned*)(lcnt + e1), 1u); lp2 = atomicAdd((unsigned*)(lcnt + e2), 1u);
        }
        }
        __syncthreads();
        if (tid < 32) { const unsigned n = lcnt[tid]; lbase[tid] = n ? atomicAdd(cnt + tid * 64, n) : 0u; }
        __syncthreads();
        if (live && fq == 0) {
            const size_t s1 = (size_t)e1 * T + lbase[e1] + lp1, s2 = (size_t)e2 * T + lbase[e2] + lp2;
            perm[s1] = row; srs[s1] = rstd; scw[s1] = c1; perm[s2] = row; srs[s2] = rstd; scw[s2] = c2;
            tokslot[row * 2] = (int)s1; tokslot[row * 2 + 1] = (int)s2;
        }
        __syncthreads();
    }
}

__device__ __forceinline__ void moe_tables(LAS unsigned char* lds, const unsigned* cnt, int tid) {
    volatile LAS int* prefix = (volatile LAS int*)(lds + LDSCTL_OFF + LC_PREFIX); volatile LAS int* ebase = (volatile LAS int*)(lds + LDSCTL_OFF + LC_EBASE); volatile LAS int* lc = (volatile LAS int*)(lds + LDSCTL_OFF + LC_CNT);
    __syncthreads();
    if (tid < NEXP) lc[tid] = (int)__hip_atomic_load(cnt + tid * 64, __ATOMIC_RELAXED, __HIP_MEMORY_SCOPE_AGENT);
    __syncthreads();
    if (tid == 0) { int pt = 0;
        for (int e = 0; e < NEXP; ++e) { const int c = lc[e]; prefix[e] = pt; ebase[e] = pt * 256; pt += (c + 255) >> 8; }
        prefix[NEXP] = pt; ebase[NEXP] = pt * 256; }
    __syncthreads();
}

__device__ __forceinline__ unsigned char* ws_ptr(ArgsP ap) { unsigned char* w = ap->ws; asm volatile("" : "+s"(w)); return w; }

#define LANEVARS int tid = threadIdx.x; asm volatile("" : "+v"(tid)); const int lane = tid & 63, wave = __builtin_amdgcn_readfirstlane(tid >> 6); const int gw = blockIdx.x * 8 + wave; const int G = gridDim.x, NGW = G * 8; (void)lane; (void)gw; (void)G; (void)NGW
#if MK_ONE_LAUNCH
#define GRID_BAR() do { XcdBarrier bar_; bar_.bar = (unsigned*)(ws_ptr(args_ptr()) + WS_CTL) + CW_BAR; bar_.x = xb_xcc_id(); bar_.st = (volatile LAS unsigned*)(lds + LDSCTL_OFF + LC_XB); xcd_barrier(bar_); } while (0)
#define PH_RANGE(k) true
#else
#define GRID_BAR() do { } while (0)
#define PH_RANGE(k) (args_ptr()->ph_lo <= (k) && (k) < args_ptr()->ph_hi)
#endif
#ifdef ONLY_PHASE
#define PH_EN(k) ((((k) % 11) == ONLY_PHASE && (k) < 22) || ((k) == 22 && ONLY_PHASE == 22))
#else
#define PH_EN(k) true
#endif
#define IN(k) (PH_EN(k) && PH_RANGE(k))
#define SEAM(k) do { if (IN(k) && IN((k) + 1)) GRID_BAR(); } while (0)
#ifdef REP_PHASE
#define NREP(k) (((k) % 11) == REP_PHASE && (k) < 22 ? 2 : 1)
#else
#define NREP(k) 1
#endif

template <int L> __device__ __forceinline__ void layer_phases(LAS unsigned char* lds) {
        const int pb = L * 11;
        for (int rep = 0; rep < NREP(pb + 0); ++rep) if (IN(pb + 0)) { if (rep) GRID_BAR(); LANEVARS; ArgsP ap = args_ptr(); phase_convert(ap, L, lds, gw, NGW, wave, lane, ap->in[I_X], 0, CONV_SPLIT, true); }
        SEAM(pb + 0);
        for (int rep = 0; rep < NREP(pb + 1); ++rep) if (IN(pb + 1)) { if (rep) GRID_BAR(); LANEVARS;
            unsigned char* ws = ws_ptr(args_ptr());
            pg8::PlainA P{(const char*)H_CUR(args_ptr(), L), D * 2, nullptr}; pg8::StaticOrder S; S.init(T, NIN, G, (int)blockIdx.x);
            pg8::EpiZ E{(bf16*)(ws + WS_ZR), (bf16*)(ws + WS_ZA), (const float*)(ws + WS_RSTD)};
            pg8::gemm_phase<pg8::PlainA, pg8::EpiZ, pg8::StaticOrder, true>(lds, P, (const char*)(ws + WS_W + W_IN), D, 0, S, E);
            {
                const int rounds = (S.nwg + G - 1) / G, nfull = S.nwg - (rounds - 1) * G; int ng = G, cr = (int)blockIdx.x;
                if (nfull < G && (G - nfull) * 4 >= G) { ng = G - nfull; cr = (int)blockIdx.x - nfull; }
                if (cr >= 0) { __syncthreads(); ArgsP ap = args_ptr(); phase_convert(ap, L, lds, cr * 8 + wave, ng * 8, wave, lane, nullptr, CONV_SPLIT, 1 << 30, false); }
            }
        }
        SEAM(pb + 1);
        for (int rep = 0; rep < NREP(pb + 3); ++rep) if (IN(pb + 3)) { if (rep) GRID_BAR(); LANEVARS;
            ArgsP ap = args_ptr();
            HeadPF pf; if ((int)blockIdx.x < NBATCH * 32) head_prefetch(ap, L, (int)blockIdx.x * 8, tid, wave, pf);
            for (int bc = blockIdx.x; bc < NBATCH * 32; bc += G) { local_tile_stage(ap, L, bc, lds, tid, wave, lane);
#pragma unroll 1
                for (int hh = 0; hh < 8; ++hh) { const int nu = (hh < 7) ? bc * 8 + hh + 1 : ((bc + G < NBATCH * 32) ? (bc + G) * 8 : -1); local_head(ap, L, bc * 8 + hh, nu, pf, lds, tid, wave, lane); } }
        }
        SEAM(pb + 3);
        for (int rep = 0; rep < NREP(pb + 4); ++rep) if (IN(pb + 4)) { if (rep) GRID_BAR(); LANEVARS;
            ArgsP ap = args_ptr();
#ifdef REP_SUB
            if (rep == 0 || REP_SUB == 1)
#endif
            for (int s = blockIdx.x; s < NBATCH * 8; s += G) chain_sequence(ap, L, s, lds, tid, wave, lane);
#ifdef REP_SUB
            if (rep == 0 || REP_SUB == 2)
#endif
            attn_phase(ap, L, rep, lds, tid, wave, lane);
        }
        SEAM(pb + 4);
        if (IN(pb + 5)) { LANEVARS;
            ArgsP ap = args_ptr(); unsigned char* ws = ws_ptr(ap);
            { const float* p = ap->in[I_P] + (size_t)L * T * 256; bf16* PB = (bf16*)(ws + WS_PB);
              const size_t npc = (size_t)T * 256 / 8, stride = (size_t)NGW * 64;
              for (size_t c8 = (size_t)gw * 64 + lane; c8 < npc; c8 += 4 * stride) { f32x4 x0[4], x1[4];
#pragma unroll
                  for (int q = 0; q < 4; ++q) { const size_t cc = (c8 + q * stride < npc) ? c8 + q * stride : c8; x0[q] = *(const f32x4*)(p + cc * 8); x1[q] = *(const f32x4*)(p + cc * 8 + 4); }
#pragma unroll
                  for (int q = 0; q < 4; ++q) { const size_t cc = c8 + q * stride; if (cc < npc) { u32x4 w; w.x = pk2(x0[q][0], x0[q][1]); w.y = pk2(x0[q][2], x0[q][3]); w.z = pk2(x1[q][0], x1[q][1]); w.w = pk2(x1[q][2], x1[q][3]); *(u32x4*)(PB + cc * 8) = w; } } } }
            pg8::PlainA P{(const char*)(ws + WS_YC), D * 2, nullptr}; pg8::StaticOrder S; S.init(T, D, G, (int)blockIdx.x);
            pg8::EpiRes E{H_CUR(ap, L)};
            pg8::gemm_phase<pg8::PlainA, pg8::EpiRes, pg8::StaticOrder, true>(lds, P, (const char*)(ws + WS_W + W_OUT), D, 0, S, E);
        }
        SEAM(pb + 5);
        for (int rep = 0; rep < NREP(pb + 6); ++rep) if (IN(pb + 6)) { if (rep) GRID_BAR(); LANEVARS;
#ifdef REP_SUB
            if (rep == 0 || REP_SUB == 1)
#endif
            phase_router(args_ptr(), L, lds, gw, NGW, wave, lane, rep);
        }
        SEAM(pb + 6);
        for (int rep = 0; rep < NREP(pb + 7); ++rep) if (IN(pb + 7)) { if (rep) GRID_BAR(); LANEVARS;
            unsigned char* ws = ws_ptr(args_ptr());
            moe_tables(lds, (unsigned*)(ws + WS_CTL) + CW_CNT + L * 4096, tid);
            volatile LAS int* prefix = (volatile LAS int*)(lds + LDSCTL_OFF + LC_PREFIX); volatile LAS int* ebase = (volatile LAS int*)(lds + LDSCTL_OFF + LC_EBASE); volatile LAS int* lc = (volatile LAS int*)(lds + LDSCTL_OFF + LC_CNT);
            pg8::GatherA P{(const char*)H_CUR(args_ptr(), L), D * 2, (const int*)(ws + WS_PERM), lc, (volatile LAS unsigned*)(lds + LDSCTL_OFF + LC_ROT)}; pg8::MoeOrder S{prefix, ebase, 2, G, (int)blockIdx.x};
            pg8::EpiHid E{(bf16*)(ws + WS_HID), (const float*)(ws + WS_SRS), (const float*)(ws + WS_SCW), lc};
            pg8::gemm_phase<pg8::GatherA, pg8::EpiHid, pg8::MoeOrder, true>(lds, P, (const char*)(ws + WS_W + W_13), D, 512, S, E);
            {
                const int total = prefix[NEXP] * 2, rounds = (total + G - 1) / G, nfull = total - (rounds - 1) * G;
                int ng = G, cr = (int)blockIdx.x;
                if (nfull < G && (G - nfull) * 8 >= G) { ng = G - nfull; cr = (int)blockIdx.x - nfull; }
                if (cr >= 0) { __syncthreads();
                    pg8::PlainA P2{(const char*)(ws + WS_PB), 256 * 2, nullptr}; pg8::StaticOrder S2; S2.init(T, D, ng, cr);
                    pg8::EpiB E2{(bf16*)(ws + WS_PP), D};
                    pg8::gemm_phase<pg8::PlainA, pg8::EpiB, pg8::StaticOrder, true>(lds, P2, (const char*)(ws + WS_W + W_PP), 256, 0, S2, E2); }
            }
        }
        SEAM(pb + 7);
        for (int rep = 0; rep < NREP(pb + 8); ++rep) if (IN(pb + 8)) { if (rep) GRID_BAR(); LANEVARS;
            unsigned char* ws = ws_ptr(args_ptr());
#if !MK_ONE_LAUNCH || defined(ONLY_PHASE)
            moe_tables(lds, (unsigned*)(ws + WS_CTL) + CW_CNT + L * 4096, tid);
#endif
            volatile LAS int* prefix = (volatile LAS int*)(lds + LDSCTL_OFF + LC_PREFIX); volatile LAS int* ebase = (volatile LAS int*)(lds + LDSCTL_OFF + LC_EBASE);
            pg8::PlainA P{(const char*)(ws + WS_HID), 256 * 2, nullptr}; pg8::MoeOrder S{prefix, ebase, 4, G, (int)blockIdx.x};
            pg8::EpiB E{(bf16*)(ws + WS_Y2), D};
            pg8::gemm_phase<pg8::PlainA, pg8::EpiB, pg8::MoeOrder, true>(lds, P, (const char*)(ws + WS_W + W_2), 256, D, S, E);
        }
        SEAM(pb + 8);
        if (IN(pb + 9)) { LANEVARS;
            ArgsP ap = args_ptr(); unsigned char* ws = ws_ptr(ap); bf16* h = H_CUR(ap, L);
#if !MK_ONE_LAUNCH || defined(ONLY_PHASE)
            moe_tables(lds, (unsigned*)(ws + WS_CTL) + CW_CNT + L * 4096, tid);
#endif
            volatile LAS int* ebase = (volatile LAS int*)(lds + LDSCTL_OFF + LC_EBASE);
            const int* tokslot = (const int*)(ws + WS_TOKSLOT); const bf16* Y2 = (const bf16*)(ws + WS_Y2); float* RSTD = (float*)(ws + WS_RSTD);
            for (int m = gw; m < T; m += NGW) {
                const int s1 = tokslot[m * 2], s2 = tokslot[m * 2 + 1];
                const size_t r1 = (size_t)ebase[s1 >> 15] + (s1 & (T - 1)), r2 = (size_t)ebase[s2 >> 15] + (s2 & (T - 1));
                u32x4* hr = (u32x4*)(h + (size_t)m * D) + lane; const u32x4* y1 = (const u32x4*)(Y2 + r1 * D) + lane; const u32x4* y2 = (const u32x4*)(Y2 + r2 * D) + lane;
                float sq = 0.f;
#pragma unroll
                for (int j = 0; j < 2; ++j) { const u32x4 hv = hr[64 * j], p = y1[64 * j], q = y2[64 * j]; const unsigned hw[4] = {hv.x, hv.y, hv.z, hv.w}, pw[4] = {p.x, p.y, p.z, p.w}, qw[4] = {q.x, q.y, q.z, q.w}; unsigned ow[4];
#pragma unroll
                    for (int e = 0; e < 4; ++e) { const float x0 = bf_lo(hw[e]) + bf_lo(pw[e]) + bf_lo(qw[e]), x1 = bf_hi(hw[e]) + bf_hi(pw[e]) + bf_hi(qw[e]);
                        const unsigned b0 = f2bf(x0), b1 = f2bf(x1); ow[e] = b0 | (b1 << 16); const float y0 = __builtin_bit_cast(float, b0 << 16), y1f = __builtin_bit_cast(float, b1 << 16); sq += y0 * y0 + y1f * y1f; }
                    hr[64 * j] = (u32x4){ow[0], ow[1], ow[2], ow[3]}; }
                sq = wave_sum(sq);
                if (lane == 0) RSTD[m] = 1.0f / sqrtf(sq * (1.0f / D) + RMS_EPS);
            }
        }
        SEAM(pb + 9);
        for (int rep = 0; rep < NREP(pb + 10); ++rep) if (IN(pb + 10)) { if (rep) GRID_BAR(); LANEVARS;
            ArgsP ap = args_ptr(); unsigned char* ws = ws_ptr(ap);
            pg8::PlainA P{(const char*)H_CUR(ap, L), D * 2, nullptr}; pg8::StaticOrder S; S.init(T, D, G, (int)blockIdx.x);
            pg8::EpiPle E{H_CUR(ap, L), H_NXT(ap, L), (const bf16*)(ws + WS_PP), (const float*)(ws + WS_RSTD), ap->in[I_PGB] + L * D};
            pg8::gemm_phase<pg8::PlainA, pg8::EpiPle, pg8::StaticOrder, true>(lds, P, (const char*)(ws + WS_W + W_PG), D, 0, S, E);
        }
        SEAM(pb + 10);
    }

__global__ void __launch_bounds__(512, 2) fwd_kernel(Args a_unused) {
    extern __shared__ __attribute__((aligned(16))) unsigned char lds_raw[];
    LAS unsigned char* lds = (LAS unsigned char*)lds_raw;
    for (int u = threadIdx.x; u < (LDS_BYTES - LDSCTL_OFF) / 4; u += 512) ((LAS unsigned*)(lds + LDSCTL_OFF))[u] = 0u;
    __syncthreads();
    (void)xcd_barrier_post((unsigned*)(ws_ptr(args_ptr()) + WS_CTL) + CW_BAR, (volatile LAS unsigned*)(lds + LDSCTL_OFF + LC_XB));

    layer_phases<0>(lds);
    layer_phases<1>(lds);
    if (IN(22)) { LANEVARS;
        ArgsP ap = args_ptr(); const bf16* h = H_A(ap); float* out = ap->out;
        const float* fw = ap->in[I_FNW];
        for (int m = gw; m < T; m += NGW) {
            const u32x4* hr = (const u32x4*)(h + (size_t)m * D) + lane; float x[16]; float sq = 0.f;
#pragma unroll
            for (int j = 0; j < 2; ++j) { const u32x4 w = hr[64 * j]; const unsigned ww[4] = {w.x, w.y, w.z, w.w};
#pragma unroll
                for (int q = 0; q < 4; ++q) { x[j * 8 + 2 * q] = bf_lo(ww[q]); x[j * 8 + 2 * q + 1] = bf_hi(ww[q]); sq += x[j * 8 + 2 * q] * x[j * 8 + 2 * q] + x[j * 8 + 2 * q + 1] * x[j * 8 + 2 * q + 1]; } }
            sq = wave_sum(sq); const float rstd = 1.0f / sqrtf(sq * (1.0f / D) + RMS_EPS);
#pragma unroll
            for (int j = 0; j < 2; ++j) { const int c0 = 8 * lane + 512 * j; const f32x4 w0 = *(const f32x4*)(fw + c0), w1 = *(const f32x4*)(fw + c0 + 4);
                f32x4 o0, o1;
#pragma unroll
                for (int q = 0; q < 4; ++q) { o0[q] = x[j * 8 + q] * rstd * w0[q]; o1[q] = x[j * 8 + 4 + q] * rstd * w1[q]; }
                *(f32x4*)(out + (size_t)m * D + c0) = o0; *(f32x4*)(out + (size_t)m * D + c0 + 4) = o1; }
        }
    }
#undef IN
#undef SEAM
}

extern "C" void kernel_launch(void* const* d_in, const int* in_sizes, int n_in, void* d_out, int out_size, void* d_ws, size_t ws_size, hipStream_t stream) {
    static int grid = 0;
    if (grid == 0) {
        if (n_in != 33 || out_size != T * D || ws_size < WS_END) { fprintf(stderr, "kernel_launch: unexpected shapes (n_in %d out %d ws %zu)\n", n_in, out_size, ws_size); grid = -1; return; }
        int dev = 0, cus = 0;
        if (hipGetDevice(&dev) != hipSuccess || hipDeviceGetAttribute(&cus, hipDeviceAttributeMultiprocessorCount, dev) != hipSuccess) { grid = -1; return; }
        if (hipFuncSetAttribute((const void*)fwd_kernel, hipFuncAttributeMaxDynamicSharedMemorySize, LDS_BYTES) != hipSuccess) { fprintf(stderr, "kernel_launch: hipFuncSetAttribute failed\n"); grid = -1; return; }
        int per_cu = 0;
        if (hipOccupancyMaxActiveBlocksPerMultiprocessor(&per_cu, (const void*)fwd_kernel, 512, LDS_BYTES) != hipSuccess || per_cu < 1) fprintf(stderr, "kernel_launch: occupancy query says %d\n", per_cu);
        (void)hipGetLastError();
        grid = cus;
    }
    if (grid < 0) return;
    hipMemsetAsync((char*)d_ws + WS_CTL, 0, CTL_ZERO_BYTES, stream);
    Args a{};
    for (int i = 0; i < 33; ++i) a.in[i] = (const float*)d_in[i];
    a.out = (float*)d_out; a.ws = (unsigned char*)d_ws;
#if MK_ONE_LAUNCH
    a.ph_lo = 0; a.ph_hi = 23;
    hipLaunchKernelGGL(fwd_kernel, dim3(grid), dim3(512), LDS_BYTES, stream, a);
#else
    for (int ph = 0; ph < 23; ++ph) { a.ph_lo = ph; a.ph_hi = ph + 1; hipLaunchKernelGGL(fwd_kernel, dim3(grid), dim3(512), LDS_BYTES, stream, a); }
#endif
}
```

```cpp
#include <hip/hip_runtime.h>
#include <cstdio>
#include <cstdint>

#ifndef LOCAL_REP
#define LOCAL_REP 0
#endif
#ifndef MK_ONE_LAUNCH
#define MK_ONE_LAUNCH 1
#endif

#define LAS __attribute__((address_space(3)))
#define GAS __attribute__((address_space(1)))
typedef unsigned short bf16;
typedef short bf16x8 __attribute__((ext_vector_type(8)));
typedef short s16x4 __attribute__((ext_vector_type(4)));
typedef float f32x4 __attribute__((ext_vector_type(4)));
typedef float f32x2 __attribute__((ext_vector_type(2)));
typedef float f32x16 __attribute__((ext_vector_type(16)));
typedef unsigned u32x4 __attribute__((ext_vector_type(4)));
typedef unsigned u32x2 __attribute__((ext_vector_type(2)));

constexpr int T = 32768, D = 1024, SEQ = 2048, NBATCH = 16;
constexpr int NIN = 3328, NR = 1792, NA = 1536, NEXP = 32;
constexpr int HIDROWS = 2 * T + NEXP * 256;
constexpr float RMS_EPS = 1e-6f, GN_EPS = 64e-5f;

constexpr size_t MiB = 1u << 20;
constexpr size_t WS_CTL = 0, CTL_ZERO_BYTES = 1 * MiB;
constexpr size_t WS_TAB = 1 * MiB;
constexpr size_t TAB_WRH = 0, TAB_WRL = 96 * 1024, TAB_W2T = 256 * 1024, TAB_A2T = 320 * 1024, TAB_G2T = 384 * 1024, TAB_V2T = 512 * 1024, TAB_V1T = 544 * 1024;
constexpr size_t WS_W = 4 * MiB;
constexpr size_t W_IN = 0, W_OUT = 6656 * 1024, W_13 = 8704 * 1024, W_2 = (8704 + 32768) * 1024, W_PG = (8704 + 49152) * 1024, W_PP = (8704 + 49152 + 2048) * 1024;
constexpr size_t WS_XB = 64 * MiB;
constexpr size_t WS_PR = 64 * MiB, WS_PK = 96 * MiB;
constexpr size_t WS_ZR = 128 * MiB;
constexpr size_t WS_YC = 128 * MiB, WS_HID = 128 * MiB;
constexpr size_t WS_Y2 = 192 * MiB;
constexpr size_t WS_ZA = 240 * MiB;
constexpr size_t WS_PV = 336 * MiB, WS_PA = 368 * MiB, WS_PG = 400 * MiB, WS_PL = 432 * MiB;
constexpr size_t WS_PP = 336 * MiB;
constexpr size_t WS_PB = 400 * MiB;
constexpr size_t WS_VF = 464 * MiB;
constexpr size_t WS_PERM = 496 * MiB, WS_SRS = 500 * MiB, WS_SCW = 504 * MiB, WS_TOKSLOT = 508 * MiB, WS_RSTD = 509 * MiB;
constexpr size_t WS_WE = 510 * MiB, WS_BS = 511 * MiB;
constexpr size_t WS_END = 512 * MiB;
constexpr int CW_BAR = 4096, CW_QUEUE = 8192, CW_CNT = 16384;

constexpr int RING_BYTES = 131072, LDSCTL_OFF = 160768, LDS_BYTES = 163840;
constexpr int LC_XB = 0, LC_PREFIX = 64, LC_EBASE = 256, LC_CNT = 512, LC_Q = 768, LC_ROT = 1024;

__device__ __forceinline__ unsigned f2bf(float f) { unsigned u = __builtin_bit_cast(unsigned, f); return (u + 0x7fffu + ((u >> 16) & 1u)) >> 16; }
typedef __bf16 bf16x2_t __attribute__((ext_vector_type(2)));
__device__ __forceinline__ unsigned pk2(float lo, float hi) { const f32x2 v = {lo, hi}; const bf16x2_t b = __builtin_convertvector(v, bf16x2_t); return __builtin_bit_cast(unsigned, b); }
__device__ __forceinline__ float bf_lo(unsigned w) { return __builtin_bit_cast(float, w << 16); }
__device__ __forceinline__ float bf_hi(unsigned w) { return __builtin_bit_cast(float, w & 0xffff0000u); }
__device__ __forceinline__ float bf2f(bf16 b) { return __builtin_bit_cast(float, ((unsigned)b) << 16); }
__device__ __forceinline__ void lds_barrier() { asm volatile("s_waitcnt lgkmcnt(0)" ::: "memory"); __builtin_amdgcn_s_barrier(); asm volatile("" ::: "memory"); }
#ifndef WT_STORES
#define WT_STORES 1
#endif
__device__ __forceinline__ void st16_wt(void* p, u32x4 v) {
#if WT_STORES
    asm volatile("global_store_dwordx4 %0, %1, off sc1\n\ts_nop 1" :: "v"(p), "v"(v) : "memory");
#else
    *(u32x4*)p = v;
#endif
}
__device__ __forceinline__ void st8_wt(void* p, u32x2 v) {
#if WT_STORES
    asm volatile("global_store_dwordx2 %0, %1, off sc1\n\ts_nop 1" :: "v"(p), "v"(v) : "memory");
#else
    *(u32x2*)p = v;
#endif
}
__device__ __forceinline__ float sigmoidf_(float x) { return __builtin_amdgcn_rcpf(1.0f + __expf(-x)); }
__device__ __forceinline__ float dpp_f(float v, const int ctrl_sel) {
    int x = __builtin_bit_cast(int, v), r;
    if (ctrl_sel == 0) r = __builtin_amdgcn_update_dpp(0, x, 0xB1, 0xf, 0xf, true);
    else if (ctrl_sel == 1) r = __builtin_amdgcn_update_dpp(0, x, 0x4E, 0xf, 0xf, true);
    else r = __builtin_amdgcn_update_dpp(0, x, 0x141, 0xf, 0xf, true);
    return __builtin_bit_cast(float, r);
}
__device__ __forceinline__ float red8(float v) { v += dpp_f(v, 0); v += dpp_f(v, 1); v += dpp_f(v, 2); return v; }
__device__ __forceinline__ void swap16(float& a, float& b) { asm volatile("s_nop 1\n\tv_permlane16_swap_b32 %0, %1" : "+v"(a), "+v"(b)); }
__device__ __forceinline__ void swap32(float& a, float& b) { asm volatile("s_nop 1\n\tv_permlane32_swap_b32 %0, %1" : "+v"(a), "+v"(b)); }
__device__ __forceinline__ float rows16_sum(float v) { float a = v, b = v; swap16(a, b); return a + b; }
__device__ __forceinline__ float rows32_sum(float v) { float a = v, b = v; swap32(a, b); return a + b; }
__device__ __forceinline__ float rows16_max(float v) { float a = v, b = v; swap16(a, b); return fmaxf(a, b); }
__device__ __forceinline__ float rows32_max(float v) { float a = v, b = v; swap32(a, b); return fmaxf(a, b); }
__device__ __forceinline__ float wave_sum(float v) {
    v = red8(v); { int x = __builtin_bit_cast(int, v); v += __builtin_bit_cast(float, __builtin_amdgcn_update_dpp(0, x, 0x140, 0xf, 0xf, true)); }
    return rows32_sum(rows16_sum(v));
}

#define XB_TMO      128
#define XB_XCNT(j)  (256  + 64 * (j))
#define XB_XSUB(j)  (1280 + 64 * (j))
#define XB_XGEN(j)  (2304 + 64 * (j))
#define XB_TOP      3328
#define XB_TOPGEN   3392
#define XCD_BAR_WORDS 3456
#define XB_SPIN_CAP (1u << 18)
__device__ __forceinline__ unsigned xb_ld(unsigned* p)              { return __hip_atomic_load(p, __ATOMIC_RELAXED, __HIP_MEMORY_SCOPE_AGENT); }
__device__ __forceinline__ unsigned xb_add(unsigned* p, unsigned v) { return __hip_atomic_fetch_add(p, v, __ATOMIC_RELAXED, __HIP_MEMORY_SCOPE_AGENT); }
__device__ __forceinline__ unsigned xb_xcc_id() { return (unsigned)__builtin_amdgcn_s_getreg((3 << 11) | 20) & 0xFu; }
#define XB_SPIN(cond, bar) do { unsigned _sp = 0; while (cond) { __builtin_amdgcn_s_sleep(1); \
    if ((++_sp & 255u) == 0u) { if (xb_ld(&(bar)[XB_TMO])) break; if (_sp > XB_SPIN_CAP) { atomicAdd(&(bar)[XB_TMO], 1u); break; } } } } while (0)
struct XcdBarrier { unsigned* bar; unsigned x; volatile LAS unsigned* st; };
__device__ __forceinline__ XcdBarrier xcd_barrier_post(unsigned* bar, volatile LAS unsigned* st) {
    XcdBarrier b; b.bar = bar; b.x = xb_xcc_id(); b.st = st;
    if (threadIdx.x == 0) (void)xb_add(&bar[XB_XCNT(b.x)], 1u);
    return b;
}
__device__ __forceinline__ void xcd_barrier_complete(unsigned* bar, unsigned x, unsigned& nloc, unsigned& nx) {
    const unsigned G = gridDim.x * gridDim.y * gridDim.z;
    unsigned sum, cnt, mine, sp = 0u;
    for (;;) {
        sum = 0u; cnt = 0u; mine = 0u;
#pragma unroll
        for (unsigned j = 0; j < 16; ++j) { const unsigned c = xb_ld(&bar[XB_XCNT(j)]); sum += c; cnt += (c > 0u) ? 1u : 0u; mine = (j == x) ? c : mine; }
        if (sum == G) break;
        __builtin_amdgcn_s_sleep(1);
        if ((++sp & 255u) == 0u) { if (xb_ld(&bar[XB_TMO])) break; if (sp > XB_SPIN_CAP) { atomicAdd(&bar[XB_TMO], 1u); break; } }
    }
    nloc = mine > 0u ? mine : 1u; nx = cnt > 0u ? cnt : 1u;
}
__device__ __forceinline__ void xcd_barrier(const XcdBarrier& b) {
    asm volatile("s_waitcnt vmcnt(0)" ::: "memory");
    __syncthreads();
    if (threadIdx.x == 0) {
        unsigned* bar = b.bar;
        __builtin_amdgcn_s_waitcnt(0);
        unsigned nloc = b.st[0], nx = b.st[1];
        if (nloc == 0u) { xcd_barrier_complete(bar, b.x, nloc, nx); b.st[0] = nloc; b.st[1] = nx; }
        const unsigned old = xb_add(&bar[XB_XSUB(b.x)], 1u);
        const unsigned gen = old / nloc;
        if (old + 1u == (gen + 1u) * nloc) {
            __builtin_amdgcn_fence(__ATOMIC_RELEASE, "agent");
            asm volatile("s_waitcnt vmcnt(0)" ::: "memory");
            const unsigned og = xb_add(&bar[XB_TOP], 1u);
            const unsigned tg = og / nx;
            if (og + 1u == (tg + 1u) * nx) xb_add(&bar[XB_TOPGEN], 1u);
            else XB_SPIN(xb_ld(&bar[XB_TOPGEN]) == tg, bar);
            __builtin_amdgcn_fence(__ATOMIC_ACQUIRE, "agent");
            xb_add(&bar[XB_XGEN(b.x)], 1u);
            asm volatile("s_waitcnt vmcnt(0)" ::: "memory");
        } else {
            XB_SPIN(xb_ld(&bar[XB_XGEN(b.x)]) == gen, bar);
            __builtin_amdgcn_fence(__ATOMIC_ACQUIRE, "agent");
            asm volatile("s_waitcnt vmcnt(0)" ::: "memory");
        }
    }
    __syncthreads();
}

namespace pg8 {
constexpr int BM = 256, BK = 64, HALF = 128, HTB = HALF * BK * 2, NXCD = 8, WGM = 4;
__device__ __forceinline__ int lds_byte(int r, int c) { const int st = (r >> 4) * 2 + (c >> 5), rr = r & 15, cc = c & 31, ob = rr * 64 + cc * 2; return st * 1024 + (ob ^ (((ob >> 9) & 1) << 5)); }
__device__ __forceinline__ void stage_rc(int b, int& R, int& C) { const int st = b / 1024, sb = b % 1024, swz = sb ^ (((sb >> 9) & 1) << 5); R = (st >> 1) * 16 + swz / 64; C = (st & 1) * 32 + (swz % 64) / 2; }
__device__ __forceinline__ int perm32(int rho) { const int n = rho >> 4, i = rho & 15; return 8 * (i >> 2) + 4 * n + (i & 3); }
__device__ __forceinline__ unsigned cvt_pk_bf16(float lo, float hi) { return pk2(lo, hi); }

struct Unit { int pn, e, row0, pos0; };

struct StaticOrder {
    int nM, nN, nwg, G, c;
    __device__ void init(int M, int N, int G_, int c_) { nM = M / BM; nN = N / BM; nwg = nM * nN; G = G_; c = c_; }
    __device__ __forceinline__ bool next(int i, Unit& u) const {
        const long L = (long)i * G + c; if (L >= nwg) return false;
        int wgid = (int)L; { const int q = nwg / NXCD, r = nwg % NXCD, xcd = wgid % NXCD, off = wgid / NXCD; wgid = (xcd < r ? xcd * (q + 1) : r * (q + 1) + (xcd - r) * q) + off; }
        const int nig = WGM * nN, gid = wgid / nig, fm = gid * WGM, gsz = (nM - fm) < WGM ? (nM - fm) : WGM;
        const int pm = fm + ((wgid % nig) % gsz); u.pn = (wgid % nig) / gsz; u.e = 0; u.row0 = pm * BM; u.pos0 = 0; return true;
    }
};
struct MoeOrder {
    const volatile LAS int* prefix; const volatile LAS int* ebase; int ncol, G, c;
    __device__ __forceinline__ bool next(int i, Unit& u) const {
        const int L = i * G + c; const int total = prefix[NEXP] * ncol; if (L >= total) return false;
        const int tile = L / ncol; u.pn = L - tile * ncol;
        int e = 0;
#pragma unroll 1
        for (int j = 1; j < NEXP; ++j) e += (prefix[j] <= tile) ? 1 : 0;
        u.e = e; u.pos0 = (tile - prefix[e]) * BM; u.row0 = ebase[e] + u.pos0; return true;
    }
};

struct PlainA { static constexpr bool GATHER = false; const char* A; int lda2;    volatile LAS unsigned* rot;
    __device__ __forceinline__ unsigned row_off(const Unit& u, int r) const { return (unsigned)(u.row0 + r) * (unsigned)lda2; } };
struct GatherA { static constexpr bool GATHER = true; const char* A; int lda2; const int* perm; const volatile LAS int* cnt; volatile LAS unsigned* rot;
    __device__ __forceinline__ unsigned row_off(const Unit& u, int r) const { const int pos = u.pos0 + r; const int tok = pos < cnt[u.e] ? perm[(size_t)u.e * T + pos] : 0; return (unsigned)tok * (unsigned)lda2; } };

template <class AP, class Epi, class Sched, bool ALIGN_EPI>
__device__ __forceinline__ void gemm_phase(LAS unsigned char* lds, const AP& P, const char* Bt, const int K, const int Nexp  , const Sched& S, const Epi& E) {
    int tid_ = threadIdx.x; asm volatile("" : "+v"(tid_));
    const int tid = tid_, wid = __builtin_amdgcn_readfirstlane(tid >> 6), lane = tid & 63, wr = wid >> 2, wc = wid & 3, fr = lane & 15, fq = lane >> 4;
    const int nt = K / BK;
    unsigned voffA[2], voffB[2][2];
#pragma unroll
    for (int i = 0; i < 2; ++i) { int R, C; stage_rc(tid * 16 + i * 8192, R, C); voffA[i] = (unsigned)R * (unsigned)P.lda2 + (unsigned)C * 2u;
#pragma unroll
        for (int hb = 0; hb < 2; ++hb) { const int Rb = Epi::WIDE ? (64 * (R >> 5) + 32 * hb + perm32(R & 31)) : (128 * hb + (Epi::PERM ? ((R & ~31) + perm32(R & 31)) : R)); voffB[hb][i] = (unsigned)(Rb * K + C) * 2u; } }
    const size_t kstep = (size_t)(BK * 2);
    const size_t hstepA = (size_t)HALF * P.lda2;
    const unsigned ldsw = (unsigned)wid * 1024u;
    const int aoff = lds_byte(wr * 64 + fr, fq * 8), boff = lds_byte(wc * 32 + fr, fq * 8);
#define PG8_SA(b, h) (((b) * 2 + (h)) * HTB)
#define PG8_SB(b, h) ((4 + (b) * 2 + (h)) * HTB)
#define PG8_STAGE_B(bufoff, hb_, gbase) do { _Pragma("unroll") for (int _i = 0; _i < 2; ++_i) \
        __builtin_amdgcn_global_load_lds((const unsigned*)((const char*)(gbase) + voffB[hb_][_i]), (LAS unsigned*)(lds + (bufoff) + ldsw + _i * 8192), 16, 0, 0); } while (0)
#define PG8_STAGE_A(bufoff, hf, kb) do { _Pragma("unroll") for (int _i = 0; _i < 2; ++_i) { \
        const char* _g; if constexpr (AP::GATHER) _g = P.A + (size_t)(kb) + (P.rot[sslot * 256 + (hf) * HALF + gR0 + 64 * _i] + gC2); else _g = sA + (size_t)(kb) + ((hf) ? hstepA : (size_t)0) + voffA[_i]; \
        __builtin_amdgcn_global_load_lds((const unsigned*)_g, (LAS unsigned*)(lds + (bufoff) + ldsw + _i * 8192), 16, 0, 0); } } while (0)
#define PG8_LDA(dst, b, h) do { _Pragma("unroll") for (int m = 0; m < 4; ++m) _Pragma("unroll") for (int k = 0; k < 2; ++k) dst[m][k] = *(const LAS bf16x8*)(lds + PG8_SA(b, h) + aoff + m * 2048 + k * 1024); } while (0)
#define PG8_LDB(dst, b, h) do { _Pragma("unroll") for (int n = 0; n < 2; ++n) _Pragma("unroll") for (int k = 0; k < 2; ++k) dst[n][k] = *(const LAS bf16x8*)(lds + PG8_SB(b, h) + boff + n * 2048 + k * 1024); } while (0)
#define PG8_MMA(ai, bj, At, Bt_) do { __builtin_amdgcn_s_setprio(1); _Pragma("unroll") for (int m = 0; m < 4; ++m) _Pragma("unroll") for (int n = 0; n < 2; ++n) _Pragma("unroll") for (int k = 0; k < 2; ++k) \
        acc[ai][bj][m][n] = __builtin_amdgcn_mfma_f32_16x16x32_bf16(Bt_[n][k], At[m][k], acc[ai][bj][m][n], 0, 0, 0); __builtin_amdgcn_s_setprio(0); } while (0)
#define PG8_WAIT_V(n) asm volatile("s_waitcnt vmcnt(" #n ")" ::: "memory")
#define PG8_WAIT_L(n) asm volatile("s_waitcnt lgkmcnt(" #n ")" ::: "memory")
#define PG8_BAR __builtin_amdgcn_s_barrier()
#define PG8_SCHED __builtin_amdgcn_sched_barrier(0)
#define PG8_ROWOFFS(u, sl) do { if (tid < 256) P.rot[(sl) * 256 + tid] = P.row_off(u, tid); } while (0)
    int gR0 = 0; unsigned gC2 = 0u; { int R, C; stage_rc(tid * 16, R, C); gR0 = R; gC2 = (unsigned)C * 2u; }
    int sslot = 0;
    Unit cur, nxt; int ui = 0;
    if (!S.next(0, cur)) return;
    f32x4 acc[2][2][4][2];
#pragma unroll
    for (int a = 0; a < 2; ++a)
#pragma unroll
        for (int b = 0; b < 2; ++b)
#pragma unroll
            for (int m = 0; m < 4; ++m)
#pragma unroll
                for (int n = 0; n < 2; ++n) acc[a][b][m][n] = (f32x4){0.f, 0.f, 0.f, 0.f};
    bf16x8 At[4][2], B0[2][2], B1[2][2];
    const char* sA = P.A; const char* sB = Bt + ((size_t)cur.e * Nexp + (size_t)cur.pn * BM) * K * 2;
    if constexpr (AP::GATHER) { PG8_ROWOFFS(cur, 0); __syncthreads(); } else { sA = P.A + (size_t)cur.row0 * P.lda2; }
    PG8_STAGE_B(PG8_SB(0, 0), 0, sB); PG8_STAGE_B(PG8_SB(0, 1), 1, sB); PG8_STAGE_A(PG8_SA(0, 0), 0, 0); PG8_STAGE_A(PG8_SA(0, 1), 1, 0);
    if (wr == 1) PG8_BAR;
    PG8_WAIT_V(2); PG8_BAR;
    PG8_STAGE_B(PG8_SB(1, 0), 0, sB + kstep); PG8_STAGE_A(PG8_SA(1, 0), 0, kstep); PG8_STAGE_B(PG8_SB(1, 1), 1, sB + kstep);
    PG8_WAIT_V(6); PG8_BAR;
    for (;;) {
        const bool has_next = S.next(ui + 1, nxt);
        const char* nB = has_next ? Bt + ((size_t)nxt.e * Nexp + (size_t)nxt.pn * BM) * K * 2 : sB;
        const char* nA = sA;
        if constexpr (AP::GATHER) { if (has_next) { PG8_ROWOFFS(nxt, (ui + 1) & 1); } }
        else { if (has_next) nA = P.A + (size_t)nxt.row0 * P.lda2; }
#pragma unroll 1
        for (int t = 0; t < nt; t += 2) {
            const bool last = (t == nt - 2);
            PG8_LDB(B0, 0, 0); PG8_LDB(B1, 0, 1); PG8_SCHED; PG8_LDA(At, 0, 0); PG8_STAGE_A(PG8_SA(1, 1), 1, (size_t)(t + 1) * kstep);
            PG8_WAIT_V(8); PG8_WAIT_L(0); PG8_BAR; PG8_MMA(0, 0, At, B0); PG8_MMA(0, 1, At, B1); PG8_BAR; PG8_SCHED;
            size_t kb2 = (size_t)(t + 2) * kstep;
            if (last) { kb2 = 0; sB = nB; sA = nA; if (has_next) sslot = (ui + 1) & 1; }
            PG8_LDA(At, 0, 1); PG8_STAGE_B(PG8_SB(0, 0), 0, sB + kb2); PG8_STAGE_B(PG8_SB(0, 1), 1, sB + kb2); PG8_STAGE_A(PG8_SA(0, 0), 0, kb2);
            PG8_WAIT_V(8); PG8_WAIT_L(0); PG8_BAR; PG8_MMA(1, 0, At, B0); PG8_MMA(1, 1, At, B1); PG8_BAR; PG8_SCHED;
            PG8_LDB(B0, 1, 0); PG8_LDB(B1, 1, 1); PG8_SCHED; PG8_LDA(At, 1, 0); PG8_STAGE_A(PG8_SA(0, 1), 1, kb2);
            PG8_WAIT_V(8); PG8_WAIT_L(0); PG8_BAR; PG8_MMA(0, 0, At, B0); PG8_MMA(0, 1, At, B1); PG8_BAR; PG8_SCHED;
            PG8_LDA(At, 1, 1); PG8_STAGE_B(PG8_SB(1, 0), 0, sB + kb2 + kstep); PG8_STAGE_B(PG8_SB(1, 1), 1, sB + kb2 + kstep); PG8_STAGE_A(PG8_SA(1, 0), 0, kb2 + kstep);
            PG8_WAIT_V(8); PG8_WAIT_L(0); PG8_BAR; PG8_MMA(1, 0, At, B0); PG8_MMA(1, 1, At, B1); PG8_BAR; PG8_SCHED;
        }
        if constexpr (ALIGN_EPI) { if (wr == 0) PG8_BAR; }
        E(acc, cur, wr, wc, fr, fq);
        if (!has_next) break;
#pragma unroll
        for (int a = 0; a < 2; ++a)
#pragma unroll
            for (int b = 0; b < 2; ++b)
#pragma unroll
                for (int m = 0; m < 4; ++m)
#pragma unroll
                    for (int n = 0; n < 2; ++n) acc[a][b][m][n] = (f32x4){0.f, 0.f, 0.f, 0.f};
        cur = nxt; ++ui;
        if constexpr (ALIGN_EPI) { if (wr == 1) PG8_BAR; }
    }
    PG8_WAIT_V(0);
    if constexpr (!ALIGN_EPI) { if (wr == 0) PG8_BAR; }
    PG8_BAR;
#undef PG8_SA
#undef PG8_SB
#undef PG8_STAGE_A
#undef PG8_STAGE_B
#undef PG8_LDA
#undef PG8_LDB
#undef PG8_MMA
#undef PG8_WAIT_V
#undef PG8_WAIT_L
#undef PG8_BAR
#undef PG8_SCHED
#undef PG8_ROWOFFS
}

typedef const f32x4 (&AccRef)[2][2][4][2];
__device__ __forceinline__ unsigned ror8(unsigned x) { return (unsigned)__builtin_amdgcn_update_dpp(0, (int)x, 0x128, 0xf, 0xf, false); }
__device__ __forceinline__ u32x4 ror8v(u32x4 v) { return (u32x4){ror8(v.x), ror8(v.y), ror8(v.z), ror8(v.w)}; }
__device__ __forceinline__ void wide_swap(u32x4 p0, u32x4 p1, int fr, u32x4& q0, u32x4& q1) {
    const bool lo = fr < 8; const u32x4 snd = lo ? p1 : p0; const u32x4 rcv = ror8v(snd);
    q0 = lo ? p0 : rcv; q1 = lo ? rcv : p1;
}
struct EpiZ { static constexpr bool PERM = true, WIDE = true; bf16* Zr; bf16* Za; const float* rstd;
    __device__ __forceinline__ void operator()(AccRef acc, const Unit& u, int wr, int wc, int fr, int fq) const {
        bf16* base; int ldc, colt;
        if (u.pn < 7) { base = Zr; ldc = NR; colt = u.pn * BM; } else { base = Za; ldc = NA; colt = (u.pn - 7) * BM; }
        const int col0 = colt + wc * 64 + (fr >> 3) * 32 + 8 * fq;
        float sv[2][4];
#pragma unroll
        for (int ai = 0; ai < 2; ++ai)
#pragma unroll
            for (int m = 0; m < 4; ++m) sv[ai][m] = rstd[u.row0 + ai * HALF + wr * 64 + m * 16 + fr];
#pragma unroll
        for (int ai = 0; ai < 2; ++ai)
#pragma unroll
            for (int m = 0; m < 4; ++m) { const int rb = u.row0 + ai * HALF + wr * 64 + m * 16; const float s = sv[ai][m];
                const f32x4 a0 = acc[ai][0][m][0] * s, a1 = acc[ai][0][m][1] * s, b0 = acc[ai][1][m][0] * s, b1 = acc[ai][1][m][1] * s;
                u32x4 p0, p1, q0, q1; p0.x = cvt_pk_bf16(a0[0], a0[1]); p0.y = cvt_pk_bf16(a0[2], a0[3]); p0.z = cvt_pk_bf16(a1[0], a1[1]); p0.w = cvt_pk_bf16(a1[2], a1[3]);
                p1.x = cvt_pk_bf16(b0[0], b0[1]); p1.y = cvt_pk_bf16(b0[2], b0[3]); p1.z = cvt_pk_bf16(b1[0], b1[1]); p1.w = cvt_pk_bf16(b1[2], b1[3]);
                wide_swap(p0, p1, fr, q0, q1);
                bf16* rp = base + (size_t)(rb + (fr & 7)) * ldc + col0; st16_wt(rp, q0); st16_wt(rp + (size_t)8 * ldc, q1); }
    }
};
struct EpiB { static constexpr bool PERM = true, WIDE = true; bf16* O; int ldc;
    __device__ __forceinline__ void operator()(AccRef acc, const Unit& u, int wr, int wc, int fr, int fq) const {
        const int col0 = u.pn * BM + wc * 64 + (fr >> 3) * 32 + 8 * fq;
#pragma unroll
        for (int ai = 0; ai < 2; ++ai)
#pragma unroll
            for (int m = 0; m < 4; ++m) { const int rb = u.row0 + ai * HALF + wr * 64 + m * 16;
                const f32x4 a0 = acc[ai][0][m][0], a1 = acc[ai][0][m][1], b0 = acc[ai][1][m][0], b1 = acc[ai][1][m][1];
                u32x4 p0, p1, q0, q1; p0.x = cvt_pk_bf16(a0[0], a0[1]); p0.y = cvt_pk_bf16(a0[2], a0[3]); p0.z = cvt_pk_bf16(a1[0], a1[1]); p0.w = cvt_pk_bf16(a1[2], a1[3]);
                p1.x = cvt_pk_bf16(b0[0], b0[1]); p1.y = cvt_pk_bf16(b0[2], b0[3]); p1.z = cvt_pk_bf16(b1[0], b1[1]); p1.w = cvt_pk_bf16(b1[2], b1[3]);
                wide_swap(p0, p1, fr, q0, q1);
                bf16* rp = O + (size_t)(rb + (fr & 7)) * ldc + col0; st16_wt(rp, q0); st16_wt(rp + (size_t)8 * ldc, q1); }
    }
};
__device__ __forceinline__ u32x4 add_bf16x8(u32x4 h, u32x4 d) {
    u32x4 o; o.x = cvt_pk_bf16(bf_lo(h.x) + bf_lo(d.x), bf_hi(h.x) + bf_hi(d.x)); o.y = cvt_pk_bf16(bf_lo(h.y) + bf_lo(d.y), bf_hi(h.y) + bf_hi(d.y));
    o.z = cvt_pk_bf16(bf_lo(h.z) + bf_lo(d.z), bf_hi(h.z) + bf_hi(d.z)); o.w = cvt_pk_bf16(bf_lo(h.w) + bf_lo(d.w), bf_hi(h.w) + bf_hi(d.w)); return o; }
struct EpiRes { static constexpr bool PERM = true, WIDE = true; bf16* h;
    __device__ __forceinline__ void operator()(AccRef acc, const Unit& u, int wr, int wc, int fr, int fq) const {
        const int col0 = u.pn * BM + wc * 64 + (fr >> 3) * 32 + 8 * fq; const bool lo = fr < 8;
#pragma unroll
        for (int ai = 0; ai < 2; ++ai) {
            u32x4 hv0[4], hv1[4];
#pragma unroll
            for (int m = 0; m < 4; ++m) { const bf16* rp = h + (size_t)(u.row0 + ai * HALF + wr * 64 + m * 16 + (fr & 7)) * D + col0; hv0[m] = *(const u32x4*)rp; hv1[m] = *(const u32x4*)(rp + (size_t)8 * D); }
#pragma unroll
            for (int m = 0; m < 4; ++m) { const int rb = u.row0 + ai * HALF + wr * 64 + m * 16; bf16* rp = h + (size_t)(rb + (fr & 7)) * D + col0;
                const u32x4 h0 = hv0[m], h1 = hv1[m];
                const f32x4 a0 = acc[ai][0][m][0], a1 = acc[ai][0][m][1], b0 = acc[ai][1][m][0], b1 = acc[ai][1][m][1];
                u32x4 snd; { const f32x4 s0 = lo ? b0 : a0, s1 = lo ? b1 : a1; snd.x = cvt_pk_bf16(s0[0], s0[1]); snd.y = cvt_pk_bf16(s0[2], s0[3]); snd.z = cvt_pk_bf16(s1[0], s1[1]); snd.w = cvt_pk_bf16(s1[2], s1[3]); }
                const u32x4 rcv = ror8v(snd);
                const f32x4 k0 = lo ? a0 : b0, k1 = lo ? a1 : b1;
                const u32x4 hk = lo ? h0 : h1, hr_ = lo ? h1 : h0;
                u32x4 ok; ok.x = cvt_pk_bf16(bf_lo(hk.x) + k0[0], bf_hi(hk.x) + k0[1]); ok.y = cvt_pk_bf16(bf_lo(hk.y) + k0[2], bf_hi(hk.y) + k0[3]); ok.z = cvt_pk_bf16(bf_lo(hk.z) + k1[0], bf_hi(hk.z) + k1[1]); ok.w = cvt_pk_bf16(bf_lo(hk.w) + k1[2], bf_hi(hk.w) + k1[3]);
                const u32x4 orr = add_bf16x8(hr_, rcv);
                st16_wt(rp, lo ? ok : orr); st16_wt(rp + (size_t)8 * D, lo ? orr : ok); }
        }
    }
};
struct EpiPle { static constexpr bool PERM = true, WIDE = true; const bf16* hin; bf16* hout; const bf16* PP; const float* rstd; const float* bg;
    __device__ __forceinline__ void operator()(AccRef acc, const Unit& u, int wr, int wc, int fr, int fq) const {
        const int colw = u.pn * BM + wc * 64 + 8 * fq; const int col0 = colw + (fr >> 3) * 32;
        const f32x4 g00 = *(const f32x4*)(bg + colw), g01 = *(const f32x4*)(bg + colw + 4), g10 = *(const f32x4*)(bg + colw + 32), g11 = *(const f32x4*)(bg + colw + 36);
        float sv[2][4];
#pragma unroll
        for (int ai = 0; ai < 2; ++ai)
#pragma unroll
            for (int m = 0; m < 4; ++m) sv[ai][m] = rstd[u.row0 + ai * HALF + wr * 64 + m * 16 + fr];
#pragma unroll
        for (int am = 0; am < 4; ++am) { const int ai = am >> 1;
            u32x4 hv0[2], hv1[2], pv0[2], pv1[2];
#pragma unroll
            for (int mm = 0; mm < 2; ++mm) { const int m = (am & 1) * 2 + mm; const size_t off = (size_t)(u.row0 + ai * HALF + wr * 64 + m * 16 + (fr & 7)) * D + col0;
                hv0[mm] = *(const u32x4*)(hin + off); hv1[mm] = *(const u32x4*)(hin + off + (size_t)8 * D); pv0[mm] = *(const u32x4*)(PP + off); pv1[mm] = *(const u32x4*)(PP + off + (size_t)8 * D); }
#pragma unroll
            for (int mm = 0; mm < 2; ++mm) { const int m = (am & 1) * 2 + mm; const int rb = u.row0 + ai * HALF + wr * 64 + m * 16; const float s = sv[ai][m]; const size_t off = (size_t)(rb + (fr & 7)) * D + col0;
                const u32x4 h0 = hv0[mm], h1 = hv1[mm], pp0 = pv0[mm], pp1 = pv1[mm];
                const f32x4 a0 = acc[ai][0][m][0] * s + g00, a1 = acc[ai][0][m][1] * s + g01, b0 = acc[ai][1][m][0] * s + g10, b1 = acc[ai][1][m][1] * s + g11;
                u32x4 p0, p1, q0, q1;
                p0.x = cvt_pk_bf16(sigmoidf_(a0[0]), sigmoidf_(a0[1])); p0.y = cvt_pk_bf16(sigmoidf_(a0[2]), sigmoidf_(a0[3])); p0.z = cvt_pk_bf16(sigmoidf_(a1[0]), sigmoidf_(a1[1])); p0.w = cvt_pk_bf16(sigmoidf_(a1[2]), sigmoidf_(a1[3]));
                p1.x = cvt_pk_bf16(sigmoidf_(b0[0]), sigmoidf_(b0[1])); p1.y = cvt_pk_bf16(sigmoidf_(b0[2]), sigmoidf_(b0[3])); p1.z = cvt_pk_bf16(sigmoidf_(b1[0]), sigmoidf_(b1[1])); p1.w = cvt_pk_bf16(sigmoidf_(b1[2]), sigmoidf_(b1[3]));
                wide_swap(p0, p1, fr, q0, q1);
#define PLE_OUT(hv, gv, pv) ((u32x4){cvt_pk_bf16(bf_lo(hv.x) + bf_lo(gv.x) * bf_lo(pv.x), bf_hi(hv.x) + bf_hi(gv.x) * bf_hi(pv.x)), cvt_pk_bf16(bf_lo(hv.y) + bf_lo(gv.y) * bf_lo(pv.y), bf_hi(hv.y) + bf_hi(gv.y) * bf_hi(pv.y)), \
                                     cvt_pk_bf16(bf_lo(hv.z) + bf_lo(gv.z) * bf_lo(pv.z), bf_hi(hv.z) + bf_hi(gv.z) * bf_hi(pv.z)), cvt_pk_bf16(bf_lo(hv.w) + bf_lo(gv.w) * bf_lo(pv.w), bf_hi(hv.w) + bf_hi(gv.w) * bf_hi(pv.w))})
                st16_wt(hout + off, PLE_OUT(h0, q0, pp0)); st16_wt(hout + off + (size_t)8 * D, PLE_OUT(h1, q1, pp1));
#undef PLE_OUT
            }
        }
    }
};
struct EpiHid { static constexpr bool PERM = true, WIDE = false; bf16* HID; const float* srs; const float* scw; const volatile LAS int* cnt;
    __device__ __forceinline__ void operator()(AccRef acc, const Unit& u, int wr, int wc, int fr, int fq) const {
        const int rl0 = wr * 64 + fr; const int col0 = u.pn * HALF + wc * 32 + 8 * fq; const int ce = cnt[u.e];
        float rsv[2][4], cwv[2][4];
#pragma unroll
        for (int ai = 0; ai < 2; ++ai)
#pragma unroll
            for (int m = 0; m < 4; ++m) { int pos = u.pos0 + rl0 + ai * HALF + m * 16; const bool ok = pos < ce; pos = ok ? pos : 0; const float r_ = srs[(size_t)u.e * T + pos], c_ = scw[(size_t)u.e * T + pos]; rsv[ai][m] = ok ? r_ : 0.f; cwv[ai][m] = ok ? c_ : 0.f; }
#pragma unroll
        for (int ai = 0; ai < 2; ++ai)
#pragma unroll
            for (int m = 0; m < 4; ++m) { const int rl = rl0 + ai * HALF + m * 16;
                const float rs = rsv[ai][m], cw = cwv[ai][m];
                float o[8];
#pragma unroll
                for (int n = 0; n < 2; ++n)
#pragma unroll
                    for (int j = 0; j < 4; ++j) { const float g = acc[ai][0][m][n][j] * rs, up = acc[ai][1][m][n][j] * rs; o[n * 4 + j] = g * sigmoidf_(g) * up * cw; }
                u32x4 w; w.x = cvt_pk_bf16(o[0], o[1]); w.y = cvt_pk_bf16(o[2], o[3]); w.z = cvt_pk_bf16(o[4], o[5]); w.w = cvt_pk_bf16(o[6], o[7]);
                st16_wt(HID + (size_t)(u.row0 + rl) * 256 + col0, w); }
    }
};
}

struct Args { const float* in[33]; float* out; unsigned char* ws; int ph_lo, ph_hi; };
typedef const Args __attribute__((address_space(4)))* ArgsP;
#define H_A(ap_) ((bf16*)((ap_)->ws + WS_XB))
#define H_B(ap_) ((bf16*)((unsigned char*)(ap_)->out + 64 * MiB))
#define H_CUR(ap_, L_) ((L_) == 0 ? H_A(ap_) : H_B(ap_))
#define H_NXT(ap_, L_) ((L_) == 0 ? H_B(ap_) : H_A(ap_))
#define P_R(ap_) ((bf16*)(ap_)->out)
#define P_K(ap_) ((bf16*)((unsigned char*)(ap_)->out + 32 * MiB))
__device__ __forceinline__ ArgsP args_ptr() { ArgsP p = (ArgsP)__builtin_amdgcn_kernarg_segment_ptr(); asm volatile("" : "+s"(p)); return p; }
enum { I_X = 0, I_P, I_NMIX, I_WIN, I_MU, I_W0, I_W2, I_A0, I_A2, I_G2, I_KK, I_KA, I_RK, I_LNW, I_LNB, I_V0, I_V1, I_V2, I_RELB, I_WOUT, I_NFFN, I_RGW, I_RGB, I_REW, I_REB,
       I_EW1, I_EW3, I_EW2, I_NPLE, I_PGW, I_PGB, I_PPW, I_FNW };

__device__ __forceinline__ void transpose_item(const float* W, int ldw, int k0, int n0, const float* scale, bf16* WT, int ldt, int drow0, LAS float* scr, int lane) {
    const int ln = lane & 7, lk = lane >> 3;
    f32x4 v[8];
#pragma unroll
    for (int i = 0; i < 8; ++i) v[i] = *(const f32x4*)(W + (size_t)(k0 + lk + 8 * i) * ldw + n0 + 4 * ln);
    if (scale) {
#pragma unroll
        for (int i = 0; i < 8; ++i) v[i] = v[i] * scale[k0 + lk + 8 * i];
    }
#pragma unroll
    for (int i = 0; i < 8; ++i) { LAS float* d = scr + (lk + 8 * i) * 33 + 4 * ln; d[0] = v[i][0]; d[1] = v[i][1]; d[2] = v[i][2]; d[3] = v[i][3]; }
    asm volatile("s_waitcnt lgkmcnt(0)" ::: "memory");
    const int c = lane & 7;
#pragma unroll
    for (int j = 0; j < 4; ++j) { const int n = (lane >> 3) + 8 * j; const LAS float* s = scr + (8 * c) * 33 + n;
        u32x4 o; o.x = pk2(s[0 * 33], s[1 * 33]); o.y = pk2(s[2 * 33], s[3 * 33]); o.z = pk2(s[4 * 33], s[5 * 33]); o.w = pk2(s[6 * 33], s[7 * 33]);
        *(u32x4*)(WT + (size_t)(drow0 + n) * ldt + k0 + 8 * c) = o; }
    asm volatile("s_waitcnt lgkmcnt(0)" ::: "memory");
}
struct TItem { const float* W; const float* scale; bf16* WT; int ldw, ldt, drow0, k0, n0, use; };
__device__ __forceinline__ void ti_load(const TItem& t, int lane, f32x4 (&v)[8], float (&sc)[8]) {
    const int ln = lane & 7, lk = lane >> 3;
#pragma unroll
    for (int i = 0; i < 8; ++i) v[i] = *(const f32x4*)(t.W + (size_t)(t.k0 + lk + 8 * i) * t.ldw + t.n0 + 4 * ln);
#pragma unroll
    for (int i = 0; i < 8; ++i) sc[i] = t.scale[t.k0 + lk + 8 * i];
}
__device__ __forceinline__ void ti_finish(const TItem& t, const f32x4 (&v)[8], const float (&sc)[8], LAS float* scr, int lane) {
    const int ln = lane & 7, lk = lane >> 3;
#pragma unroll
    for (int i = 0; i < 8; ++i) { const f32x4 w = v[i] * (t.use ? sc[i] : 1.0f); LAS float* d = scr + (lk + 8 * i) * 33 + 4 * ln; d[0] = w[0]; d[1] = w[1]; d[2] = w[2]; d[3] = w[3]; }
    asm volatile("s_waitcnt lgkmcnt(0)" ::: "memory");
    const int c = lane & 7;
#pragma unroll
    for (int j = 0; j < 4; ++j) { const int n = (lane >> 3) + 8 * j; const LAS float* s_ = scr + (8 * c) * 33 + n;
        u32x4 o; o.x = pk2(s_[0 * 33], s_[1 * 33]); o.y = pk2(s_[2 * 33], s_[3 * 33]); o.z = pk2(s_[4 * 33], s_[5 * 33]); o.w = pk2(s_[6 * 33], s_[7 * 33]);
        st16_wt(t.WT + (size_t)(t.drow0 + n) * t.ldt + t.k0 + 8 * c, o); }
    asm volatile("s_waitcnt lgkmcnt(0)" ::: "memory");
}
__device__ __forceinline__ void row_to_bf16_rstd(const float* xrow, bf16* orow, float* rstd_out, int lane) {
    const f32x4* xr = (const f32x4*)xrow + lane; f32x4 v[4]; float s = 0.f;
#pragma unroll
    for (int j = 0; j < 4; ++j) { v[j] = xr[64 * j]; s += (v[j].x * v[j].x + v[j].y * v[j].y) + (v[j].z * v[j].z + v[j].w * v[j].w); }
    s = wave_sum(s);
    if (lane == 0) *rstd_out = 1.0f / sqrtf(s * (1.0f / D) + RMS_EPS);
    u32x2* o8 = (u32x2*)orow + lane;
#pragma unroll
    for (int j = 0; j < 4; ++j) { u32x2 w; w.x = pk2(v[j].x, v[j].y); w.y = pk2(v[j].z, v[j].w); o8[64 * j] = w; }
}

constexpr int CONV_EARLY = 1664 + 512 + 8192;
constexpr int CONV_SPLIT = 6144;
__device__ __forceinline__ void phase_convert(ArgsP a, int L, LAS unsigned char* lds, int gw, int NGW, int wave, int lane, const float* hsrc, int it_lo, int it_hi, bool rest) {
    unsigned char* ws = a->ws;
    LAS float* scr = (LAS float*)(lds + wave * 16384);
    bf16* Wb = (bf16*)(ws + WS_W);
    constexpr int I_IN = 16 * 104, I_OUT = 16 * 32, I_E13 = 32 * 16 * 8, I_E2 = 32 * 4 * 32, I_PG = 16 * 32, I_PPI = 4 * 32;
    constexpr int NITEMS = I_IN + I_OUT + 2 * I_E13 + I_E2 + I_PG + I_PPI;
    if (it_hi > NITEMS) it_hi = NITEMS;
    const float* ONES = a->in[I_NMIX];
#define CONV_DECODE(it_, t_) do { int r = (it_); \
        if (r < I_IN) { const int kb = r / 104, nb = r % 104; t_ = TItem{a->in[I_WIN] + (size_t)L * D * NIN, a->in[I_NMIX] + L * D, (bf16*)((char*)Wb + W_IN), NIN, D, nb * 32, kb * 64, nb * 32, 1}; break; } r -= I_IN; \
        if (r < I_OUT) { const int kb = r / 32, nb = r % 32; t_ = TItem{a->in[I_WOUT] + (size_t)L * D * D, ONES, (bf16*)((char*)Wb + W_OUT), D, D, nb * 32, kb * 64, nb * 32, 0}; break; } r -= I_OUT; \
        if (r < 2 * I_E13) { const int which = r / I_E13; r -= which * I_E13; const int e = r / 128, q = r % 128, kb = q / 8, nb = q % 8; const int n0 = nb * 32, pn = n0 >> 7; \
            t_ = TItem{(which ? a->in[I_EW3] : a->in[I_EW1]) + ((size_t)L * NEXP + e) * D * 256, a->in[I_NFFN] + L * D, (bf16*)((char*)Wb + W_13), 256, D, (e * 2 + pn) * 256 + which * 128 + (n0 & 127), kb * 64, n0, 1}; break; } r -= 2 * I_E13; \
        if (r < I_E2) { const int e = r / 128, q = r % 128, kb = q / 32, nb = q % 32; t_ = TItem{a->in[I_EW2] + ((size_t)L * NEXP + e) * 256 * D, ONES, (bf16*)((char*)Wb + W_2), D, 256, e * D + nb * 32, kb * 64, nb * 32, 0}; break; } r -= I_E2; \
        if (r < I_PG) { const int kb = r / 32, nb = r % 32; t_ = TItem{a->in[I_PGW] + (size_t)L * D * D, a->in[I_NPLE] + L * D, (bf16*)((char*)Wb + W_PG), D, D, nb * 32, kb * 64, nb * 32, 1}; break; } r -= I_PG; \
        { const int kb = r / 32, nb = r % 32; t_ = TItem{a->in[I_PPW] + (size_t)L * 256 * D, ONES, (bf16*)((char*)Wb + W_PP), D, 256, nb * 32, kb * 64, nb * 32, 0}; } } while (0)
    {
        int it = it_lo + gw;
        if (it < it_hi) {
            TItem A, B; f32x4 va[8], vb[8]; float sa[8], sb[8];
            CONV_DECODE(it, A); ti_load(A, lane, va, sa);
            for (;;) {
                const int itn = it + NGW; const bool okn = itn < it_hi; CONV_DECODE(okn ? itn : it, B); ti_load(B, lane, vb, sb);
                ti_finish(A, va, sa, scr, lane);
                if (!okn) break;
                it = itn + NGW; const bool oka = it < it_hi; CONV_DECODE(oka ? it : itn, A); ti_load(A, lane, va, sa);
                ti_finish(B, vb, sb, scr, lane);
                if (!oka) break;
            }
        }
    }
#undef CONV_DECODE
    if (!rest) return;
    const int gt = gw * 64 + lane, NGT = NGW * 64;
    bf16* WRH = (bf16*)(ws + WS_TAB + TAB_WRH); bf16* WRL = (bf16*)(ws + WS_TAB + TAB_WRL);
    bf16* w2t = (bf16*)(ws + WS_TAB + TAB_W2T); bf16* a2t = (bf16*)(ws + WS_TAB + TAB_A2T); bf16* g2t = (bf16*)(ws + WS_TAB + TAB_G2T); bf16* v2t = (bf16*)(ws + WS_TAB + TAB_V2T); bf16* v1t = (bf16*)(ws + WS_TAB + TAB_V1T);
    for (int i = gt; i < 512 * 128; i += NGT) {
        float rv = 0.f, rs = 0.f, w2v = 0.f, a2v = 0.f, v2v = 0.f, v1v = 0.f;
        const bool okr = i < 48 * D, okw = i < 512 * 64, okv = (L > 0) && i < 512 * 32;
        if (okr) { const int n = i >> 10, k = i & 1023; if (n < 4) rv = a->in[I_RGW][((size_t)L * D + k) * 4 + n]; else if (n < 36) rv = a->in[I_REW][((size_t)L * D + k) * 32 + (n - 4)]; rs = a->in[I_NFFN][L * D + k]; }
        if (okw) { const int n = i >> 6, k = i & 63; w2v = a->in[I_W2][((size_t)L * 64 + k) * 512 + n]; a2v = a->in[I_A2][((size_t)L * 64 + k) * 512 + n]; }
        const float g2v = a->in[I_G2][((size_t)L * 128 + (i & 127)) * 512 + (i >> 7)];
        if (okv) { v2v = a->in[I_V2][((size_t)(L - 1) * 32 + (i & 31)) * 512 + (i >> 5)]; v1v = a->in[I_V1][((size_t)(L - 1) * 512 + (i & 511)) * 32 + (i >> 9)]; }
        if (okr) { const float v = rv * rs; const unsigned hi = f2bf(v); const float lo = v - __builtin_bit_cast(float, hi << 16); WRH[i] = (bf16)hi; WRL[i] = (bf16)f2bf(lo); }
        if (okw) { w2t[i] = (bf16)f2bf(w2v); a2t[i] = (bf16)f2bf(a2v); }
        g2t[i] = (bf16)f2bf(g2v);
        if (okv) { v2t[i] = (bf16)f2bf(v2v); v1t[i] = (bf16)f2bf(v1v); }
    }
    float* RSTD = (float*)(ws + WS_RSTD);
    if (L == 0) { bf16* HA = H_A(a);
        for (int m = gw * 2; m < T; m += NGW * 2) {
            const f32x4* x0 = (const f32x4*)(hsrc + (size_t)m * D) + lane; const f32x4* x1 = x0 + D / 4; f32x4 v0[4], v1[4];
#pragma unroll
            for (int j = 0; j < 4; ++j) { v0[j] = x0[64 * j]; v1[j] = x1[64 * j]; }
            float s0 = 0.f, s1 = 0.f;
#pragma unroll
            for (int j = 0; j < 4; ++j) { s0 += (v0[j].x * v0[j].x + v0[j].y * v0[j].y) + (v0[j].z * v0[j].z + v0[j].w * v0[j].w); s1 += (v1[j].x * v1[j].x + v1[j].y * v1[j].y) + (v1[j].z * v1[j].z + v1[j].w * v1[j].w); }
            s0 = wave_sum(s0); s1 = wave_sum(s1);
            if (lane == 0) { RSTD[m] = 1.0f / sqrtf(s0 * (1.0f / D) + RMS_EPS); RSTD[m + 1] = 1.0f / sqrtf(s1 * (1.0f / D) + RMS_EPS); }
            u32x2* o0 = (u32x2*)(HA + (size_t)m * D) + lane; u32x2* o1 = o0 + D / 4;
#pragma unroll
            for (int j = 0; j < 4; ++j) { u32x2 w; w.x = pk2(v0[j].x, v0[j].y); w.y = pk2(v0[j].z, v0[j].w); st8_wt(o0 + 64 * j, w); w.x = pk2(v1[j].x, v1[j].y); w.y = pk2(v1[j].z, v1[j].w); st8_wt(o1 + 64 * j, w); } } }
    else { const bf16* HB = H_B(a);
        for (int m = gw * 4; m < T; m += NGW * 4) { u32x4 w[4][2];
#pragma unroll
            for (int r = 0; r < 4; ++r) { const u32x4* hr = (const u32x4*)(HB + (size_t)(m + r) * D) + lane; w[r][0] = hr[0]; w[r][1] = hr[64]; }
            float sq[4];
#pragma unroll
            for (int r = 0; r < 4; ++r) { sq[r] = 0.f;
#pragma unroll
                for (int j = 0; j < 2; ++j) { const unsigned ww[4] = {w[r][j].x, w[r][j].y, w[r][j].z, w[r][j].w};
#pragma unroll
                    for (int q = 0; q < 4; ++q) { const float x0 = bf_lo(ww[q]), x1 = bf_hi(ww[q]); sq[r] += x0 * x0 + x1 * x1; } }
                sq[r] = wave_sum(sq[r]); }
            if (lane == 0) {
#pragma unroll
                for (int r = 0; r < 4; ++r) RSTD[m + r] = 1.0f / sqrtf(sq[r] * (1.0f / D) + RMS_EPS); } } }
}

__device__ __forceinline__ bf16x8 lds_frag(const LAS bf16* base, int stride, int row, int k0) { return *(const LAS bf16x8*)(base + row * stride + k0); }
__device__ __forceinline__ void phase_prep(ArgsP a, int L, LAS unsigned char* lds, int tid, int wave, int lane, int skip) {
    unsigned char* ws = a->ws;
    const bf16* Zr = (const bf16*)(ws + WS_ZR);
    bf16* PR = P_R(a); bf16* PK = P_K(a); bf16* PV = (bf16*)(ws + (L == 0 ? WS_VF : WS_PV)); bf16* PA = (bf16*)(ws + WS_PA); bf16* PG = (bf16*)(ws + WS_PG); bf16* PL = (bf16*)(ws + WS_PL);
    const bf16* VF = (const bf16*)(ws + WS_VF);
    const bf16* w2t = (const bf16*)(ws + WS_TAB + TAB_W2T); const bf16* a2t = (const bf16*)(ws + WS_TAB + TAB_A2T); const bf16* g2t = (const bf16*)(ws + WS_TAB + TAB_G2T);
    const bf16* v2t = (const bf16*)(ws + WS_TAB + TAB_V2T); const bf16* v1t = (const bf16*)(ws + WS_TAB + TAB_V1T);
    const float* mu = a->in[I_MU] + (size_t)L * NR;
    const float* w0 = a->in[I_W0] + L * 512; const float* a0 = a->in[I_A0] + L * 512; const float* v0 = a->in[I_V0];
    constexpr int SW = 72, SG = 136, SV = 520, SVV = 40;
    LAS bf16* AW = (LAS bf16*)lds; LAS bf16* AA = AW + 64 * SW; LAS bf16* AG = AA + 64 * SW; LAS bf16* AV = AG + 64 * SG; LAS bf16* VV = AV + 64 * SV;
    const int fr = lane & 15, fq = lane >> 4;
    for (int tile = blockIdx.x; tile < T / 64; tile += gridDim.x) {
        const int t0 = tile * 64;
        __syncthreads();
        {
            const int tt = tid >> 3, ch = tid & 7, t = t0 + tt; const bool first = (t % SEQ) == 0;
            const bf16* zc = Zr + (size_t)t * NR + 1536 + ch * 32; const bf16* zp = zc - NR;
#pragma unroll
            for (int q = 0; q < 4; ++q) {
                const u32x4 c4 = *(const u32x4*)(zc + q * 8); u32x4 p4 = (u32x4){0u, 0u, 0u, 0u}; if (!first) p4 = *(const u32x4*)(zp + q * 8);
                const f32x4 m0 = *(const f32x4*)(mu + 1536 + ch * 32 + q * 8), m1 = *(const f32x4*)(mu + 1536 + ch * 32 + q * 8 + 4);
                float z[8];
                const unsigned cw[4] = {c4.x, c4.y, c4.z, c4.w}, pw[4] = {p4.x, p4.y, p4.z, p4.w};
#pragma unroll
                for (int j = 0; j < 4; ++j) { const float c0 = bf_lo(cw[j]), c1 = bf_hi(cw[j]), p0 = bf_lo(pw[j]), p1 = bf_hi(pw[j]);
                    const float ma = (j < 2) ? m0[2 * j] : m1[2 * j - 4], mb = (j < 2) ? m0[2 * j + 1] : m1[2 * j - 3];
                    z[2 * j] = c0 + (p0 - c0) * ma; z[2 * j + 1] = c1 + (p1 - c1) * mb; }
                if (ch < 2) {
#pragma unroll
                    for (int j = 0; j < 8; ++j) z[j] = tanhf(z[j]);
                } else if (ch >= 4) {
#pragma unroll
                    for (int j = 0; j < 8; ++j) z[j] = sigmoidf_(z[j]);
                }
                u32x4 o; o.x = pk2(z[0], z[1]); o.y = pk2(z[2], z[3]); o.z = pk2(z[4], z[5]); o.w = pk2(z[6], z[7]);
                LAS bf16* dst = (ch < 2) ? (AW + tt * SW + ch * 32 + q * 8) : (ch < 4) ? (AA + tt * SW + (ch - 2) * 32 + q * 8) : (AG + tt * SG + (ch - 4) * 32 + q * 8);
                *(LAS u32x4*)dst = o;
            }
            if (L > 0) {
                const bf16* vc = Zr + (size_t)t * NR + 1024 + ch * 64; const bf16* vp = vc - NR;
#pragma unroll
                for (int q = 0; q < 8; ++q) {
                    const u32x4 c4 = *(const u32x4*)(vc + q * 8); u32x4 p4 = (u32x4){0u, 0u, 0u, 0u}; if (!first) p4 = *(const u32x4*)(vp + q * 8);
                    const f32x4 m0 = *(const f32x4*)(mu + 1024 + ch * 64 + q * 8), m1 = *(const f32x4*)(mu + 1024 + ch * 64 + q * 8 + 4);
                    float z[8]; const unsigned cw[4] = {c4.x, c4.y, c4.z, c4.w}, pw[4] = {p4.x, p4.y, p4.z, p4.w};
#pragma unroll
                    for (int j = 0; j < 4; ++j) { const float c0 = bf_lo(cw[j]), c1 = bf_hi(cw[j]), p0 = bf_lo(pw[j]), p1 = bf_hi(pw[j]);
                        const float ma = (j < 2) ? m0[2 * j] : m1[2 * j - 4], mb = (j < 2) ? m0[2 * j + 1] : m1[2 * j - 3];
                        z[2 * j] = c0 + (p0 - c0) * ma; z[2 * j + 1] = c1 + (p1 - c1) * mb; }
                    u32x4 o; o.x = pk2(z[0], z[1]); o.y = pk2(z[2], z[3]); o.z = pk2(z[4], z[5]); o.w = pk2(z[6], z[7]);
                    *(LAS u32x4*)(AV + tt * SV + ch * 64 + q * 8) = o;
                }
            }
        }
        __syncthreads();
        if (L > 0) {
            const int m = wave & 3, nt2 = wave >> 2; f32x4 c = (f32x4){0.f, 0.f, 0.f, 0.f};
#pragma unroll 4
            for (int ks = 0; ks < 16; ++ks) { const bf16x8 wf = *(const bf16x8*)(v1t + (size_t)(nt2 * 16 + fr) * 512 + ks * 32 + fq * 8); const bf16x8 af = lds_frag(AV, SV, m * 16 + fr, ks * 32 + fq * 8);
                c = __builtin_amdgcn_mfma_f32_16x16x32_bf16(wf, af, c, 0, 0, 0); }
            u32x2 o; o.x = pk2(c[0], c[1]); o.y = pk2(c[2], c[3]);
            *(LAS u32x2*)(VV + (m * 16 + fr) * SVV + nt2 * 16 + fq * 4) = o;
            __syncthreads();
        }
#pragma unroll
        for (int which = 0; which < 3; ++which) { if (skip == 1) continue;
            f32x4 acc[4][4];
#pragma unroll
            for (int m = 0; m < 4; ++m)
#pragma unroll
                for (int nt = 0; nt < 4; ++nt) acc[m][nt] = (f32x4){0.f, 0.f, 0.f, 0.f};
            const int KS = (which == 2) ? 4 : 2; const bf16* wt = (which == 0) ? w2t : (which == 1) ? a2t : g2t; const int ldw = (which == 2) ? 128 : 64;
            const LAS bf16* Ab = (which == 0) ? AW : (which == 1) ? AA : AG; const int sa = (which == 2) ? SG : SW;
#pragma unroll
            for (int ks = 0; ks < KS; ++ks) {
                bf16x8 af[4];
#pragma unroll
                for (int m = 0; m < 4; ++m) af[m] = lds_frag(Ab, sa, m * 16 + fr, ks * 32 + fq * 8);
#pragma unroll
                for (int nt = 0; nt < 4; ++nt) { const bf16x8 wf = *(const bf16x8*)(wt + (size_t)(wave * 64 + nt * 16 + fr) * ldw + ks * 32 + fq * 8);
#pragma unroll
                    for (int m = 0; m < 4; ++m) acc[m][nt] = __builtin_amdgcn_mfma_f32_16x16x32_bf16(wf, af[m], acc[m][nt], 0, 0, 0); }
            }
#pragma unroll
            for (int m = 0; m < 4; ++m)
#pragma unroll
                for (int nt = 0; nt < 4; ++nt) { const int t = t0 + m * 16 + fr, n0 = wave * 64 + nt * 16 + fq * 4; f32x4 v = acc[m][nt]; u32x2 o;
                    if (which == 0) { const f32x4 b = *(const f32x4*)(w0 + n0);
#pragma unroll
                        for (int j = 0; j < 4; ++j) v[j] = -0.6065306597f * sigmoidf_(v[j] + b[j]);
                        o.x = pk2(v[0], v[1]); o.y = pk2(v[2], v[3]); *(u32x2*)(PL + (size_t)t * 512 + n0) = o; }
                    else if (which == 1) { const f32x4 b = *(const f32x4*)(a0 + n0);
#pragma unroll
                        for (int j = 0; j < 4; ++j) v[j] = sigmoidf_(v[j] + b[j]);
                        o.x = pk2(v[0], v[1]); o.y = pk2(v[2], v[3]); *(u32x2*)(PA + (size_t)t * 512 + n0) = o; }
                    else { o.x = pk2(v[0], v[1]); o.y = pk2(v[2], v[3]); *(u32x2*)(PG + (size_t)t * 512 + n0) = o; } }
        }
        LAS bf16* SGm = AV;
        if (L > 0) {
#pragma unroll
            for (int nt = 0; nt < 4; ++nt) { const bf16x8 wf = *(const bf16x8*)(v2t + (size_t)(wave * 64 + nt * 16 + fr) * 32 + fq * 8); const int n0 = wave * 64 + nt * 16 + fq * 4; const f32x4 vb = *(const f32x4*)(v0 + n0);
#pragma unroll
                for (int m = 0; m < 4; ++m) { const bf16x8 af = lds_frag(VV, SVV, m * 16 + fr, fq * 8); const f32x4 av = __builtin_amdgcn_mfma_f32_16x16x32_bf16(wf, af, (f32x4){0.f, 0.f, 0.f, 0.f}, 0, 0, 0);
                    u32x2 o; o.x = pk2(sigmoidf_(vb[0] + av[0]), sigmoidf_(vb[1] + av[1])); o.y = pk2(sigmoidf_(vb[2] + av[2]), sigmoidf_(vb[3] + av[3]));
                    *(LAS u32x2*)(SGm + (m * 16 + fr) * SV + n0) = o; } }
            __syncthreads();
        }
#pragma unroll 2
        for (int it = 0; it < 8; ++it) { if (skip == 2) continue; const int idx = tid + 512 * it, tl = idx >> 6, c8 = (idx & 63) * 8; const int t = t0 + tl; const bool first = (t % SEQ) == 0;
#pragma unroll
            for (int which = 0; which < 3; ++which) { const bf16* zc = Zr + (size_t)t * NR + which * 512 + c8; const u32x4 c4 = *(const u32x4*)zc; u32x4 p4 = (u32x4){0u, 0u, 0u, 0u}; if (!first) p4 = *(const u32x4*)(zc - NR);
                const f32x4 m0 = *(const f32x4*)(mu + which * 512 + c8), m1 = *(const f32x4*)(mu + which * 512 + c8 + 4);
                float z[8]; const unsigned cw[4] = {c4.x, c4.y, c4.z, c4.w}, pw[4] = {p4.x, p4.y, p4.z, p4.w};
#pragma unroll
                for (int j = 0; j < 4; ++j) { const float c0 = bf_lo(cw[j]), c1 = bf_hi(cw[j]), p0 = bf_lo(pw[j]), p1 = bf_hi(pw[j]);
                    const float ma = (j < 2) ? m0[2 * j] : m1[2 * j - 4], mb = (j < 2) ? m0[2 * j + 1] : m1[2 * j - 3];
                    z[2 * j] = c0 + (p0 - c0) * ma; z[2 * j + 1] = c1 + (p1 - c1) * mb; }
                if (which == 2 && L > 0) { const u32x4 f4 = *(const u32x4*)(VF + (size_t)t * 512 + c8); const u32x4 s4 = *(const LAS u32x4*)(SGm + tl * SV + c8);
                    const unsigned fw[4] = {f4.x, f4.y, f4.z, f4.w}, sw[4] = {s4.x, s4.y, s4.z, s4.w};
#pragma unroll
                    for (int j = 0; j < 4; ++j) { z[2 * j] += (bf_lo(fw[j]) - z[2 * j]) * bf_lo(sw[j]); z[2 * j + 1] += (bf_hi(fw[j]) - z[2 * j + 1]) * bf_hi(sw[j]); } }
                u32x4 o; o.x = pk2(z[0], z[1]); o.y = pk2(z[2], z[3]); o.z = pk2(z[4], z[5]); o.w = pk2(z[6], z[7]);
                bf16* dst = (which == 0) ? PR : (which == 1) ? PK : PV; *(u32x4*)(dst + (size_t)t * 512 + c8) = o; } }
    }
}

__device__ __forceinline__ s16x4 vtr(const LAS bf16* p) { typedef short v4i16_t __attribute__((ext_vector_type(4))); return __builtin_bit_cast(s16x4, __builtin_amdgcn_ds_read_tr16_b64_v4i16((LAS v4i16_t*)p)); }
#ifndef MX_SWZ
#define MX_SWZ 1
#endif
constexpr int SM = MX_SWZ ? 64 : 72;
constexpr int SMA = 72;
__device__ __forceinline__ int MO(int row, int col) {
#if MX_SWZ
    return row * 64 + ((((col >> 3) ^ ((row & 3) | ((row & 8) >> 1))) << 3) | (col & 7));
#else
    return row * SM + col;
#endif
}
constexpr int MSZ = 64 * SM;
__device__ __forceinline__ bf16x8 frag_n(const LAS bf16* M, int idx0, int k0, int fr, int fq) { return *(const LAS bf16x8*)(M + MO(idx0 + fr, k0 + fq * 8)); }
__device__ __forceinline__ bf16x8 frag_t(const LAS bf16* M, int idx0, int k0, int fr, int fq) {
    const int r_ = k0 + 8 * fq + (fr >> 2), c_ = idx0 + 4 * (fr & 3);
    const u32x2 v0 = __builtin_bit_cast(u32x2, vtr(M + MO(r_, c_))), v1 = __builtin_bit_cast(u32x2, vtr(M + MO(r_ + 4, c_)));
    return __builtin_bit_cast(bf16x8, (u32x4){v0.x, v0.y, v1.x, v1.y});
}
template <bool FT, bool ST>
__device__ __forceinline__ f32x4 mm_tile(const LAS bf16* Fm, const LAS bf16* Sm_, int f0, int s0, f32x4 acc, int fr, int fq) {
#pragma unroll
    for (int ks = 0; ks < 2; ++ks) {
        const bf16x8 ff = FT ? frag_t(Fm, f0, ks * 32, fr, fq) : frag_n(Fm, f0, ks * 32, fr, fq);
        const bf16x8 sf = ST ? frag_t(Sm_, s0, ks * 32, fr, fq) : frag_n(Sm_, s0, ks * 32, fr, fq);
        acc = __builtin_amdgcn_mfma_f32_16x16x32_bf16(ff, sf, acc, 0, 0, 0);
    }
    return acc;
}
__device__ __forceinline__ void st_tile(LAS bf16* Z, int f0, int s0, f32x4 v, int fr, int fq) {
    u32x2 o; o.x = pk2(v[0], v[1]); o.y = pk2(v[2], v[3]); *(LAS u32x2*)(Z + MO(s0 + fr, f0 + 4 * fq)) = o;
}
__device__ __forceinline__ void st_tile_g(bf16* Z, int f0, int s0, f32x4 v, int fr, int fq) {
    u32x2 o; o.x = pk2(v[0], v[1]); o.y = pk2(v[2], v[3]); *(u32x2*)(Z + (size_t)(s0 + fr) * 512 + f0 + 4 * fq) = o;
}

constexpr int LT_SG = 136, LT_SV = 520, LT_SVV = 40;
constexpr int LT_AW = 119808, LT_AA = LT_AW + 9216, LT_AG = LT_AA + 9216, LT_VV = LT_AG + 17408;
static_assert(LT_VV + 5120 == LDSCTL_OFF, "LDS map");
__device__ __forceinline__ void local_tile_stage(ArgsP a, int L, int bc, LAS unsigned char* lds, int tid_in, int wave, int lane_in) {
    int tid = tid_in; asm volatile("" : "+v"(tid)); const int lane = tid & 63;
    unsigned char* ws = a->ws;
    const bf16* Zr = (const bf16*)(ws + WS_ZR); const bf16* v1t = (const bf16*)(ws + WS_TAB + TAB_V1T);
    const float* mu = a->in[I_MU] + (size_t)L * NR;
    const size_t tok0 = (size_t)bc * 64;
    LAS bf16* AV = (LAS bf16*)lds;
    LAS bf16* AW = (LAS bf16*)(lds + LT_AW); LAS bf16* AA = (LAS bf16*)(lds + LT_AA); LAS bf16* AG = (LAS bf16*)(lds + LT_AG); LAS bf16* VV = (LAS bf16*)(lds + LT_VV);
    const int fr = lane & 15, fq = lane >> 4;
    __syncthreads();
#pragma unroll
    for (int it = 0; it < 4; ++it) {
        const int idx = tid + 512 * it, tl = idx >> 5, c8 = idx & 31; const size_t t = tok0 + tl; const bool first = (t % SEQ) == 0;
        const bf16* zc = Zr + t * NR + 1536 + c8 * 8; const u32x4 c4 = *(const u32x4*)zc; u32x4 p4 = (u32x4){0u, 0u, 0u, 0u}; if (!first) p4 = *(const u32x4*)(zc - NR);
        const f32x4 m0 = *(const f32x4*)(mu + 1536 + c8 * 8), m1 = *(const f32x4*)(mu + 1536 + c8 * 8 + 4);
        float z[8]; const unsigned cw_[4] = {c4.x, c4.y, c4.z, c4.w}, pw_[4] = {p4.x, p4.y, p4.z, p4.w};
#pragma unroll
        for (int j = 0; j < 4; ++j) { const float c0 = bf_lo(cw_[j]), c1 = bf_hi(cw_[j]), p0 = bf_lo(pw_[j]), p1 = bf_hi(pw_[j]);
            const float ma = (j < 2) ? m0[2 * j] : m1[2 * j - 4], mb = (j < 2) ? m0[2 * j + 1] : m1[2 * j - 3];
            z[2 * j] = c0 + (p0 - c0) * ma; z[2 * j + 1] = c1 + (p1 - c1) * mb; }
        if (c8 < 8) {
#pragma unroll
            for (int j = 0; j < 8; ++j) { const float e = __expf(2.0f * z[j]); z[j] = 1.0f - 2.0f * __builtin_amdgcn_rcpf(e + 1.0f); }
        } else if (c8 >= 16) {
#pragma unroll
            for (int j = 0; j < 8; ++j) z[j] = __builtin_amdgcn_rcpf(1.0f + __expf(-z[j]));
        }
        u32x4 o; o.x = pk2(z[0], z[1]); o.y = pk2(z[2], z[3]); o.z = pk2(z[4], z[5]); o.w = pk2(z[6], z[7]);
        LAS bf16* dst = (c8 < 8) ? (AW + tl * SMA + c8 * 8) : (c8 < 16) ? (AA + tl * SMA + (c8 - 8) * 8) : (AG + tl * LT_SG + (c8 - 16) * 8);
        *(LAS u32x4*)dst = o;
    }
    if (L > 0) {
#pragma unroll
        for (int it = 0; it < 8; ++it) { const int idx = tid + 512 * it, tl = idx >> 6, c8 = idx & 63; const size_t t = tok0 + tl; const bool first = (t % SEQ) == 0;
            const bf16* zc = Zr + t * NR + 1024 + c8 * 8; const u32x4 c4 = *(const u32x4*)zc; u32x4 p4 = (u32x4){0u, 0u, 0u, 0u}; if (!first) p4 = *(const u32x4*)(zc - NR);
            const f32x4 m0 = *(const f32x4*)(mu + 1024 + c8 * 8), m1 = *(const f32x4*)(mu + 1024 + c8 * 8 + 4);
            float z[8]; const unsigned cw_[4] = {c4.x, c4.y, c4.z, c4.w}, pw_[4] = {p4.x, p4.y, p4.z, p4.w};
#pragma unroll
            for (int j = 0; j < 4; ++j) { const float c0 = bf_lo(cw_[j]), c1 = bf_hi(cw_[j]), p0 = bf_lo(pw_[j]), p1 = bf_hi(pw_[j]);
                const float ma = (j < 2) ? m0[2 * j] : m1[2 * j - 4], mb = (j < 2) ? m0[2 * j + 1] : m1[2 * j - 3];
                z[2 * j] = c0 + (p0 - c0) * ma; z[2 * j + 1] = c1 + (p1 - c1) * mb; }
            u32x4 o; o.x = pk2(z[0], z[1]); o.y = pk2(z[2], z[3]); o.z = pk2(z[4], z[5]); o.w = pk2(z[6], z[7]);
            *(LAS u32x4*)(AV + tl * LT_SV + c8 * 8) = o; }
        __syncthreads();
        const int m = wave & 3, nt2 = wave >> 2; f32x4 c = (f32x4){0.f, 0.f, 0.f, 0.f};
#pragma unroll
        for (int ks = 0; ks < 16; ++ks) { const bf16x8 wf = *(const bf16x8*)(v1t + (size_t)(nt2 * 16 + fr) * 512 + ks * 32 + fq * 8); const bf16x8 af = *(const LAS bf16x8*)(AV + (m * 16 + fr) * LT_SV + ks * 32 + fq * 8);
            c = __builtin_amdgcn_mfma_f32_16x16x32_bf16(wf, af, c, 0, 0, 0); }
        u32x2 o; o.x = pk2(c[0], c[1]); o.y = pk2(c[2], c[3]);
        *(LAS u32x2*)(VV + (m * 16 + fr) * LT_SVV + nt2 * 16 + fq * 4) = o;
    }
    __syncthreads();
}

struct HeadPF { u32x4 c4[3], p4[3], vf4; f32x4 mu[6]; bf16x8 w2f[2], a2f[2], g2f[4], v2f; f32x4 kkc[2], kac[2], rkc[2], wbc, abc, vbc; };
__device__ __forceinline__ void head_prefetch(ArgsP a, int L, int unit, int tid, int wave, HeadPF& pf) {
    const bf16* Zr = (const bf16*)(a->ws + WS_ZR); const bf16* VF = (const bf16*)(a->ws + WS_VF);
    const int h = unit & 7, bc = unit >> 3, tt = tid >> 3, jc = tid & 7; const size_t t = (size_t)bc * 64 + tt; const bool first = (t % SEQ) == 0;
    const bf16* zc = Zr + t * NR + h * 64 + jc * 8;
#pragma unroll
    for (int w3 = 0; w3 < 3; ++w3) { pf.c4[w3] = *(const u32x4*)(zc + w3 * 512); pf.p4[w3] = (u32x4){0u, 0u, 0u, 0u}; if (!first) pf.p4[w3] = *(const u32x4*)(zc + w3 * 512 - NR); }
    pf.vf4 = (u32x4){0u, 0u, 0u, 0u}; if (L > 0) pf.vf4 = *(const u32x4*)(VF + t * 512 + h * 64 + jc * 8);
    const float* mu = a->in[I_MU] + (size_t)L * NR + h * 64 + jc * 8;
#pragma unroll
    for (int w3 = 0; w3 < 3; ++w3) { pf.mu[2 * w3] = *(const f32x4*)(mu + w3 * 512); pf.mu[2 * w3 + 1] = *(const f32x4*)(mu + w3 * 512 + 4); }
    const bf16* w2t = (const bf16*)(a->ws + WS_TAB + TAB_W2T); const bf16* a2t = (const bf16*)(a->ws + WS_TAB + TAB_A2T); const bf16* g2t = (const bf16*)(a->ws + WS_TAB + TAB_G2T); const bf16* v2t = (const bf16*)(a->ws + WS_TAB + TAB_V2T);
    const int fr = tid & 15, fq = (tid & 63) >> 4; const size_t wrow = (size_t)(h * 64 + 16 * (wave & 3) + fr);
#pragma unroll
    for (int ks = 0; ks < 2; ++ks) { pf.w2f[ks] = *(const bf16x8*)(w2t + wrow * 64 + ks * 32 + fq * 8); pf.a2f[ks] = *(const bf16x8*)(a2t + wrow * 64 + ks * 32 + fq * 8); }
#pragma unroll
    for (int ks = 0; ks < 4; ++ks) pf.g2f[ks] = *(const bf16x8*)(g2t + wrow * 128 + ks * 32 + fq * 8);
    pf.v2f = (bf16x8){0, 0, 0, 0, 0, 0, 0, 0}; if (L > 0) pf.v2f = *(const bf16x8*)(v2t + wrow * 32 + fq * 8);
    const int ch0 = h * 64 + jc * 8, n0c = h * 64 + 16 * (wave & 3) + 4 * fq;
#pragma unroll
    for (int q = 0; q < 2; ++q) { pf.kkc[q] = *(const f32x4*)(a->in[I_KK] + L * 512 + ch0 + 4 * q); pf.kac[q] = *(const f32x4*)(a->in[I_KA] + L * 512 + ch0 + 4 * q); pf.rkc[q] = *(const f32x4*)(a->in[I_RK] + L * 512 + ch0 + 4 * q); }
    pf.wbc = *(const f32x4*)(a->in[I_W0] + L * 512 + n0c); pf.abc = *(const f32x4*)(a->in[I_A0] + L * 512 + n0c); pf.vbc = (f32x4){0.f, 0.f, 0.f, 0.f}; if (L > 0) pf.vbc = *(const f32x4*)(a->in[I_V0] + n0c);
}
__device__ __forceinline__ void local_head(ArgsP a, int L, int unit, int next_unit, HeadPF& pf, LAS unsigned char* lds, int tid_in, int wave, int lane_in) {
    int tid = tid_in; asm volatile("" : "+v"(tid)); const int lane = tid & 63;
    unsigned char* ws = a->ws;
    const bf16* Zr = (const bf16*)(ws + WS_ZR);
    bf16* PR = P_R(a); bf16* PK = P_K(a); bf16* PV = (bf16*)(ws + (L == 0 ? WS_VF : WS_PV)); bf16* PA = (bf16*)(ws + WS_PA); bf16* PL = (bf16*)(ws + WS_PL); bf16* PG = (bf16*)(ws + WS_PG);
    const bf16* VF = (const bf16*)(ws + WS_VF);
    float* WE = (float*)(ws + WS_WE); float* BSg = (float*)(ws + WS_BS);
    const bf16* w2t = (const bf16*)(ws + WS_TAB + TAB_W2T); const bf16* a2t = (const bf16*)(ws + WS_TAB + TAB_A2T); const bf16* g2t = (const bf16*)(ws + WS_TAB + TAB_G2T);
    const bf16* v2t = (const bf16*)(ws + WS_TAB + TAB_V2T);
    const float* mu = a->in[I_MU] + (size_t)L * NR;
    const int h = unit & 7, bc = unit >> 3;
    const size_t tok0 = (size_t)bc * 64; const size_t gbase = tok0 * 512 + h * 64;
    LAS bf16* Mx = (LAS bf16*)lds;
    LAS bf16* At = Mx + 0 * MSZ; LAS bf16* Rt = Mx + 1 * MSZ; LAS bf16* Bt = Mx + 2 * MSZ; LAS bf16* Kt = Mx + 3 * MSZ; LAS bf16* Vt = Mx + 4 * MSZ; LAS bf16* Bb = Mx + 5 * MSZ; LAS bf16* Kb = Mx + 6 * MSZ;
    LAS bf16* Nak = Mx + 7 * MSZ; LAS bf16* Mrb = Mx + 8 * MSZ; LAS bf16* Mrk = Mx + 9 * MSZ; LAS bf16* Na = Mx + 10 * MSZ; LAS bf16* Pa = Mx + 11 * MSZ; LAS bf16* NakV = Mx + 12 * MSZ;
    LAS bf16* Nb = Bt; LAS bf16* Pb = Kt; LAS bf16* Uv = Na; LAS bf16* Ah = Pb;
    const LAS bf16* AW = (const LAS bf16*)(lds + LT_AW); const LAS bf16* AA = (const LAS bf16*)(lds + LT_AA); const LAS bf16* AG = (const LAS bf16*)(lds + LT_AG); const LAS bf16* VV = (const LAS bf16*)(lds + LT_VV);
    constexpr int SG_ = LT_SG, SVV = LT_SVV;
    LAS float* CW = (LAS float*)(Mx + 7 * MSZ);
    LAS float* SEG = (LAS float*)(Mx + 9 * MSZ); LAS float* CW2 = (LAS float*)(Mx + 10 * MSZ);
    LAS bf16* ASt = Mx + 3 * MSZ;
    LAS bf16* SGt = Mx + 4 * MSZ;
    const int fr = lane & 15, fq = lane >> 4;
    const int tt = tid >> 3, jc = tid & 7, ch0 = h * 64 + jc * 8;
    const int s0 = (wave & 3) * 16, fbase = (wave >> 2) * 32;
    const f32x4 Z4 = (f32x4){0.f, 0.f, 0.f, 0.f};
    for (int rp5 = 0; rp5 < (LOCAL_REP == 5 ? 2 : 1); ++rp5) {
    float r[8], k[8], v[8];
    const u32x4 vf4 = pf.vf4;
    f32x4 kkc[2], kac[2], rkc[2];
    {
        u32x4 c4[3], p4[3];
#pragma unroll
        for (int w3 = 0; w3 < 3; ++w3) { c4[w3] = pf.c4[w3]; p4[w3] = pf.p4[w3]; }
#pragma unroll
        for (int w3 = 0; w3 < 3; ++w3) { const f32x4 m0 = pf.mu[2 * w3], m1 = pf.mu[2 * w3 + 1];
            const unsigned cw_[4] = {c4[w3].x, c4[w3].y, c4[w3].z, c4[w3].w}, pw_[4] = {p4[w3].x, p4[w3].y, p4[w3].z, p4[w3].w};
#pragma unroll
            for (int j = 0; j < 4; ++j) { const float c0 = bf_lo(cw_[j]), c1 = bf_hi(cw_[j]), p0 = bf_lo(pw_[j]), p1 = bf_hi(pw_[j]);
                const float ma = (j < 2) ? m0[2 * j] : m1[2 * j - 4], mb = (j < 2) ? m0[2 * j + 1] : m1[2 * j - 3];
                const float z0 = c0 + (p0 - c0) * ma, z1 = c1 + (p1 - c1) * mb;
                if (w3 == 0) { r[2 * j] = z0; r[2 * j + 1] = z1; } else if (w3 == 1) { k[2 * j] = z0; k[2 * j + 1] = z1; } else { v[2 * j] = z0; v[2 * j + 1] = z1; } } }
    }
    const bf16x8 w2f0 = pf.w2f[0], w2f1 = pf.w2f[1], a2f0 = pf.a2f[0], a2f1 = pf.a2f[1], g2f0 = pf.g2f[0], g2f1 = pf.g2f[1], g2f2 = pf.g2f[2], g2f3 = pf.g2f[3], v2f = pf.v2f;
    lds_barrier();
#pragma unroll
    for (int q = 0; q < 2; ++q) { kkc[q] = pf.kkc[q]; kac[q] = pf.kac[q]; rkc[q] = pf.rkc[q]; }
    const f32x4 wbc = pf.wbc, abc = pf.abc, vbc = pf.vbc;
#pragma unroll
    for (int q = 0; q < 2; ++q) { const int f0 = 16 * (wave & 3); const int trow = 32 * (wave >> 2) + 16 * q + fr;
        f32x4 cw_ = Z4, ca = Z4, cg = Z4;
        cw_ = __builtin_amdgcn_mfma_f32_16x16x32_bf16(w2f0, *(const LAS bf16x8*)(AW + trow * SMA + fq * 8), cw_, 0, 0, 0); cw_ = __builtin_amdgcn_mfma_f32_16x16x32_bf16(w2f1, *(const LAS bf16x8*)(AW + trow * SMA + 32 + fq * 8), cw_, 0, 0, 0);
        ca = __builtin_amdgcn_mfma_f32_16x16x32_bf16(a2f0, *(const LAS bf16x8*)(AA + trow * SMA + fq * 8), ca, 0, 0, 0); ca = __builtin_amdgcn_mfma_f32_16x16x32_bf16(a2f1, *(const LAS bf16x8*)(AA + trow * SMA + 32 + fq * 8), ca, 0, 0, 0);
        cg = __builtin_amdgcn_mfma_f32_16x16x32_bf16(g2f0, *(const LAS bf16x8*)(AG + trow * SG_ + fq * 8), cg, 0, 0, 0); cg = __builtin_amdgcn_mfma_f32_16x16x32_bf16(g2f1, *(const LAS bf16x8*)(AG + trow * SG_ + 32 + fq * 8), cg, 0, 0, 0);
        cg = __builtin_amdgcn_mfma_f32_16x16x32_bf16(g2f2, *(const LAS bf16x8*)(AG + trow * SG_ + 64 + fq * 8), cg, 0, 0, 0); cg = __builtin_amdgcn_mfma_f32_16x16x32_bf16(g2f3, *(const LAS bf16x8*)(AG + trow * SG_ + 96 + fq * 8), cg, 0, 0, 0);
        f32x4 ldv; u32x2 o;
#pragma unroll
        for (int j = 0; j < 4; ++j) { ldv[j] = -0.6065306597f * sigmoidf_(cw_[j] + wbc[j]); ca[j] = sigmoidf_(ca[j] + abc[j]); }
        *(LAS f32x4*)(CW + trow * 64 + f0 + 4 * fq) = ldv;
        o.x = pk2(ca[0], ca[1]); o.y = pk2(ca[2], ca[3]); *(LAS u32x2*)(ASt + MO(trow, f0 + 4 * fq)) = o;
        o.x = pk2(cg[0], cg[1]); o.y = pk2(cg[2], cg[3]); *(u32x2*)(PG + gbase + (size_t)trow * 512 + f0 + 4 * fq) = o;
        if (L > 0) {
            const f32x4 cv = __builtin_amdgcn_mfma_f32_16x16x32_bf16(v2f, *(const LAS bf16x8*)(VV + trow * SVV + fq * 8), Z4, 0, 0, 0);
            o.x = pk2(sigmoidf_(vbc[0] + cv[0]), sigmoidf_(vbc[1] + cv[1])); o.y = pk2(sigmoidf_(vbc[2] + cv[2]), sigmoidf_(vbc[3] + cv[3])); *(LAS u32x2*)(SGt + MO(trow, f0 + 4 * fq)) = o; }
    }
    lds_barrier();
    float as[8], ld[8];
    { const f32x4 l0 = *(const LAS f32x4*)(CW + tt * 64 + jc * 8), l1 = *(const LAS f32x4*)(CW + tt * 64 + jc * 8 + 4); const u32x4 a4 = *(const LAS u32x4*)(ASt + MO(tt, jc * 8));
      const unsigned aw[4] = {a4.x, a4.y, a4.z, a4.w};
#pragma unroll
      for (int j = 0; j < 4; ++j) { ld[j] = l0[j]; ld[4 + j] = l1[j]; as[2 * j] = bf_lo(aw[j]); as[2 * j + 1] = bf_hi(aw[j]); } }
    {   const int j = tid & 63, sg = tid >> 6; float run = 0.f;
#pragma unroll
        for (int q = 0; q < 8; ++q) { run += CW[(sg * 8 + q) * 64 + j]; CW2[(sg * 8 + q) * 64 + j] = run; }
        SEG[sg * 64 + j] = run; }
    if (L > 0) { const u32x4 s4 = *(const LAS u32x4*)(SGt + MO(tt, jc * 8)); const unsigned sw[4] = {s4.x, s4.y, s4.z, s4.w}, fw[4] = {vf4.x, vf4.y, vf4.z, vf4.w};
#pragma unroll
        for (int j = 0; j < 4; ++j) { v[2 * j] += (bf_lo(fw[j]) - v[2 * j]) * bf_lo(sw[j]); v[2 * j + 1] += (bf_hi(fw[j]) - v[2 * j + 1]) * bf_hi(sw[j]); } }
    { u32x4 v4; v4.x = pk2(v[0], v[1]); v4.y = pk2(v[2], v[3]); v4.z = pk2(v[4], v[5]); v4.w = pk2(v[6], v[7]);
      st16_wt(PV + gbase + (size_t)tt * 512 + jc * 8, v4);
      *(LAS u32x4*)(Vt + MO(tt, jc * 8)) = v4; }
    float kp[8], ap[8], bp[8];
    { float ss = 0.f, kx[8];
#pragma unroll
      for (int j = 0; j < 8; ++j) { kx[j] = k[j] * ((j < 4) ? kkc[0][j] : kkc[1][j - 4]); ss += kx[j] * kx[j]; }
      ss = red8(ss); const float inv = __builtin_amdgcn_rsqf(fmaxf(ss, 1e-24f)); float bsum = 0.f;
#pragma unroll
      for (int j = 0; j < 8; ++j) { const float kk = kx[j] * inv; ap[j] = -kk; bp[j] = kk * as[j]; kp[j] = k[j] * (1.0f + (as[j] - 1.0f) * ((j < 4) ? kac[0][j] : kac[1][j - 4])); bsum += r[j] * kp[j] * ((j < 4) ? rkc[0][j] : rkc[1][j - 4]); }
      bsum = red8(bsum);
      if (jc == 0) BSg[(tok0 + tt) * 8 + h] = bsum; }
    lds_barrier();
    float cw[8], cwe[8];
    {
        f32x4 o0 = Z4, o1 = Z4;
#pragma unroll 1
        for (int s2 = 0; s2 < wave; ++s2) { o0 = o0 + *(const LAS f32x4*)(SEG + s2 * 64 + jc * 8); o1 = o1 + *(const LAS f32x4*)(SEG + s2 * 64 + jc * 8 + 4); }
        f32x4 e0 = o0, e1 = o1;
#pragma unroll 1
        for (int s2 = wave; s2 < 8; ++s2) { e0 = e0 + *(const LAS f32x4*)(SEG + s2 * 64 + jc * 8); e1 = e1 + *(const LAS f32x4*)(SEG + s2 * 64 + jc * 8 + 4); }
        const f32x4 c0 = *(const LAS f32x4*)(CW2 + tt * 64 + jc * 8), c1 = *(const LAS f32x4*)(CW2 + tt * 64 + jc * 8 + 4);
#pragma unroll
        for (int j = 0; j < 4; ++j) { cw[j] = c0[j] + o0[j]; cw[4 + j] = c1[j] + o1[j]; cwe[j] = e0[j]; cwe[4 + j] = e1[j]; } }
    if (tt == 0) {
#pragma unroll
        for (int j = 0; j < 8; ++j) WE[(size_t)unit * 64 + jc * 8 + j] = __expf(cwe[j]);
    }
    { float oA[8], oR[8], oB[8], oK[8], oBb[8], oKb[8];
#pragma unroll
      for (int j = 0; j < 8; ++j) { const float ein = __expf(cw[j]), eneg = __expf(-cw[j]), eex = __expf(cw[j] - ld[j]), eend = __expf(cwe[j] - cw[j]);
          oA[j] = ap[j] * eex; oR[j] = r[j] * ein; oB[j] = bp[j] * eneg; oK[j] = kp[j] * eneg; oBb[j] = bp[j] * eend; oKb[j] = kp[j] * eend; }
#define ST8(M_, o_) do { u32x4 w_; w_.x = pk2(o_[0], o_[1]); w_.y = pk2(o_[2], o_[3]); w_.z = pk2(o_[4], o_[5]); w_.w = pk2(o_[6], o_[7]); *(LAS u32x4*)(M_ + MO(tt, jc * 8)) = w_; } while (0)
      ST8(At, oA); ST8(Rt, oR); ST8(Bt, oB); ST8(Kt, oK); ST8(Bb, oBb); ST8(Kb, oKb);
#undef ST8
    }
    lds_barrier();
    }
    f32x4 pacc[2];
    for (int rp = 0; rp < (LOCAL_REP == 2 ? 2 : 1); ++rp) { if (rp) lds_barrier();
#pragma unroll
    for (int q = 0; q < 2; ++q) { const int f0 = fbase + q * 16; const int tI = s0 + fr;
        f32x4 nab = mm_tile<false, false>(Bt, At, f0, s0, Z4, fr, fq), nak = mm_tile<false, false>(Kt, At, f0, s0, Z4, fr, fq);
        f32x4 mrb = mm_tile<false, false>(Bt, Rt, f0, s0, Z4, fr, fq), mrk = mm_tile<false, false>(Kt, Rt, f0, s0, Z4, fr, fq);
#pragma unroll
        for (int g = 0; g < 4; ++g) { const int sI = f0 + 4 * fq + g; if (!(sI < tI)) { nab[g] = 0.f; nak[g] = 0.f; } if (!(sI <= tI)) { mrb[g] = 0.f; mrk[g] = 0.f; } }
        pacc[q] = nab;
#pragma unroll
        for (int g = 0; g < 4; ++g) if (f0 + 4 * fq + g == tI) pacc[q][g] += 1.0f;
        st_tile(Nak, f0, s0, nak, fr, fq); st_tile(Mrb, f0, s0, mrb, fr, fq); st_tile(Mrk, f0, s0, mrk, fr, fq); st_tile(Na, f0, s0, nab, fr, fq); st_tile(Pa, f0, s0, pacc[q], fr, fq); } }
    lds_barrier();
    if (next_unit >= 0) head_prefetch(a, L, next_unit, tid, wave, pf);
    const int dblk = wave >> 2, bk0 = 32 * dblk, bf0 = bk0 + 16 * (wave & 1), bs0 = bk0 + 16 * ((wave >> 1) & 1);
#define MMK(Fm_, ft_, Sm_, st_, f0_, s0_, k0_, acc_) __builtin_amdgcn_mfma_f32_16x16x32_bf16((ft_) ? frag_t(Fm_, f0_, k0_, fr, fq) : frag_n(Fm_, f0_, k0_, fr, fq), (st_) ? frag_t(Sm_, s0_, k0_, fr, fq) : frag_n(Sm_, s0_, k0_, fr, fq), acc_, 0, 0, 0)
    f32x4 pblk;
    { const u32x2 pp = *(const LAS u32x2*)(Pa + MO(bs0 + fr, bf0 + 4 * fq)); pblk = (f32x4){bf_lo(pp.x), bf_hi(pp.x), bf_lo(pp.y), bf_hi(pp.y)}; }
    st_tile(Nb, bf0, bs0, MMK(Na, true, Na, false, bf0, bs0, bk0, Z4), fr, fq);
#pragma unroll
    for (int q = 0; q < 2; ++q) { const int f0 = fbase + q * 16; st_tile(NakV, f0, s0, mm_tile<true, false>(Vt, Nak, f0, s0, Z4, fr, fq), fr, fq); }
    lds_barrier();
    {
        LAS bf16* Ncur = Nb; LAS bf16* Nnext = Na; LAS bf16* Pcur = Pa; LAS bf16* Pnext = Pb;
#pragma unroll 1
        for (int it = 1; it <= 4; ++it) {
            const bf16x8 nf = frag_t(Ncur, bf0, bk0, fr, fq);
            pblk = __builtin_amdgcn_mfma_f32_16x16x32_bf16(nf, frag_n(Pcur, bs0, bk0, fr, fq), pblk, 0, 0, 0);
            st_tile(Pnext, bf0, bs0, pblk, fr, fq);
            if (it < 4) st_tile(Nnext, bf0, bs0, __builtin_amdgcn_mfma_f32_16x16x32_bf16(nf, frag_n(Ncur, bs0, bk0, fr, fq), Z4, 0, 0, 0), fr, fq);
            lds_barrier();
            LAS bf16* tN = Ncur; Ncur = Nnext; Nnext = tN; LAS bf16* tP = Pcur; Pcur = Pnext; Pnext = tP;
        }
    }
    if (wave < 4) { const int mf0 = 16 * (wave & 1), ms0 = 32 + 16 * (wave >> 1); st_tile(Pb, mf0, ms0, MMK(Pa, true, Na, false, mf0, ms0, 0, Z4), fr, fq); }
    lds_barrier();
    if (wave < 4) { const int mf0 = 16 * (wave & 1), ms0 = 32 + 16 * (wave >> 1); st_tile(Pa, mf0, ms0, MMK(Pb, true, Pa, false, mf0, ms0, 32, Z4), fr, fq); }
    lds_barrier();
#undef MMK
#pragma unroll
    for (int q = 0; q < 2; ++q) { const int f0 = fbase + q * 16;
        st_tile(Uv, f0, s0, mm_tile<true, false>(NakV, Pa, f0, s0, Z4, fr, fq), fr, fq);
        st_tile(Ah, f0, s0, mm_tile<true, false>(At, Pa, f0, s0, Z4, fr, fq), fr, fq); }
    lds_barrier();
    for (int rp = 0; rp < (LOCAL_REP == 3 ? 2 : 1); ++rp)
#pragma unroll
    for (int q = 0; q < 2; ++q) { const int f0 = fbase + q * 16;
        {
            const u32x2 rr = *(const LAS u32x2*)(Rt + MO(s0 + fr, f0 + 4 * fq)); const f32x4 r0 = (f32x4){bf_lo(rr.x), bf_hi(rr.x), bf_lo(rr.y), bf_hi(rr.y)};
            st_tile_g(PR + gbase, f0, s0, mm_tile<true, false>(Ah, Mrb, f0, s0, r0, fr, fq), fr, fq); }
        {
            f32x4 y = mm_tile<true, false>(Uv, Mrb, f0, s0, Z4, fr, fq); y = mm_tile<true, false>(Vt, Mrk, f0, s0, y, fr, fq); st_tile_g(PK + gbase, f0, s0, y, fr, fq); }
        {
            st_tile_g(PA + gbase, f0, s0, mm_tile<true, true>(Ah, Bb, f0, s0, Z4, fr, fq), fr, fq); }
        {
            f32x4 hh = mm_tile<true, true>(Bb, Uv, f0, s0, Z4, fr, fq); hh = mm_tile<true, true>(Kb, Vt, f0, s0, hh, fr, fq); st_tile_g(PL + gbase, f0, s0, hh, fr, fq); }
    }
}

__device__ __forceinline__ void chain_sequence(ArgsP a, int L, int seq, LAS unsigned char* lds, int tid, int wave, int lane) {
    unsigned char* ws = a->ws;
    const bf16* PR = P_R(a); const bf16* PK = P_K(a); const bf16* PV = (const bf16*)(ws + (L == 0 ? WS_VF : WS_PV)); const bf16* PA = (const bf16*)(ws + WS_PA);
    const bf16* PG = (const bf16*)(ws + WS_PG); const bf16* PL = (const bf16*)(ws + WS_PL); bf16* YC = (bf16*)(ws + WS_YC);
    const float* WE = (const float*)(ws + WS_WE); const float* BSg = (const float*)(ws + WS_BS);
    const int b = seq >> 3, h = seq & 7;
    LAS bf16* Mx = (LAS bf16*)lds;
    LAS bf16* Sb = Mx;
    LAS float* Yf = (LAS float*)(Mx + 9 * MSZ);
    LAS float* Wl = Yf + 64 * 68;
    const int fr = lane & 15, fq = lane >> 4, tt = tid >> 3, jc = tid & 7, ch0 = h * 64 + jc * 8;
    const int s0 = (wave & 3) * 16, fbase = (wave >> 2) * 32;
    float lnw[8], lnb[8];
#pragma unroll
    for (int j = 0; j < 8; ++j) { lnw[j] = a->in[I_LNW][L * 512 + ch0 + j]; lnb[j] = a->in[I_LNB][L * 512 + ch0 + j]; }
    f32x4 sreg[2] = {(f32x4){0.f, 0.f, 0.f, 0.f}, (f32x4){0.f, 0.f, 0.f, 0.f}};
    const size_t row0 = (size_t)b * SEQ;
    __syncthreads();
    *(LAS u32x4*)(Sb + MO(tt, jc * 8)) = (u32x4){0u, 0u, 0u, 0u};
    {
        const size_t off = (row0 + tt) * 512 + ch0;
        *(LAS u32x4*)(Mx + 1 * MSZ + MO(tt, jc * 8)) = *(const u32x4*)(PA + off); *(LAS u32x4*)(Mx + 2 * MSZ + MO(tt, jc * 8)) = *(const u32x4*)(PL + off);
        *(LAS u32x4*)(Mx + 3 * MSZ + MO(tt, jc * 8)) = *(const u32x4*)(PR + off); *(LAS u32x4*)(Mx + 4 * MSZ + MO(tt, jc * 8)) = *(const u32x4*)(PK + off);
        if (tid < 64) Wl[tid] = WE[((size_t)(b * 32) * 8 + h) * 64 + tid];
    }
    struct ChT { u32x4 g, h, r, y; float wl; }; struct ChQ { u32x4 v, gg; float bon; };
    ChT T4[2]; ChQ Q4[2];
#define CH_LOADT(T_, cs_) do { const size_t off_ = (row0 + (size_t)(cs_) * 64 + tt) * 512 + ch0; T_.g = *(const u32x4*)(PA + off_); T_.h = *(const u32x4*)(PL + off_); T_.r = *(const u32x4*)(PR + off_); T_.y = *(const u32x4*)(PK + off_); \
        T_.wl = (tid < 64) ? WE[((size_t)(b * 32 + (cs_)) * 8 + h) * 64 + tid] : 0.f; } while (0)
#define CH_LOADQ(Q_, cs_) do { const size_t off_ = (row0 + (size_t)(cs_) * 64 + tt) * 512 + ch0; Q_.v = *(const u32x4*)(PV + off_); Q_.gg = *(const u32x4*)(PG + off_); Q_.bon = BSg[(row0 + (size_t)(cs_) * 64 + tt) * 8 + h]; } while (0)
#pragma unroll
    for (int u = 0; u < 2; ++u) { CH_LOADT(T4[u], u + 1); CH_LOADQ(Q4[u], u); }
#pragma unroll 1
    for (int c0 = 0; c0 < 32; c0 += 2) {
#pragma unroll
      for (int u = 0; u < 2; ++u) {
        const int c = c0 + u; const int p = u & 1;
        const LAS bf16* Gl = Mx + (1 + 4 * p) * MSZ; const LAS bf16* Ht = Gl + MSZ; const LAS bf16* Rh = Ht + MSZ; const LAS bf16* Yl = Rh + MSZ;
        __syncthreads();
        f32x4 sn[2];
        {
            bf16x8 sbf[2][2], glf[2][2], rhs[2], sbs[2]; u32x2 yy[2], hh[2]; f32x4 wv[2];
#pragma unroll
            for (int ks = 0; ks < 2; ++ks) { rhs[ks] = frag_n(Rh, s0, ks * 32, fr, fq); sbs[ks] = frag_n(Sb, s0, ks * 32, fr, fq);
#pragma unroll
                for (int q = 0; q < 2; ++q) { sbf[q][ks] = frag_n(Sb, fbase + q * 16, ks * 32, fr, fq); glf[q][ks] = frag_n(Gl, fbase + q * 16, ks * 32, fr, fq); } }
#pragma unroll
            for (int q = 0; q < 2; ++q) { const int f0 = fbase + q * 16; yy[q] = *(const LAS u32x2*)(Yl + MO(s0 + fr, f0 + 4 * fq)); hh[q] = *(const LAS u32x2*)(Ht + MO(s0 + fr, f0 + 4 * fq)); wv[q] = *(const LAS f32x4*)(Wl + p * 64 + f0 + 4 * fq); }
            __builtin_amdgcn_sched_barrier(0);
#pragma unroll
            for (int q = 0; q < 2; ++q) { const int f0 = fbase + q * 16;
                f32x4 y = (f32x4){bf_lo(yy[q].x), bf_hi(yy[q].x), bf_lo(yy[q].y), bf_hi(yy[q].y)};
                y = __builtin_amdgcn_mfma_f32_16x16x32_bf16(sbf[q][0], rhs[0], y, 0, 0, 0); y = __builtin_amdgcn_mfma_f32_16x16x32_bf16(sbf[q][1], rhs[1], y, 0, 0, 0);
                f32x4 c0v = (f32x4){bf_lo(hh[q].x), bf_hi(hh[q].x), bf_lo(hh[q].y), bf_hi(hh[q].y)};
                c0v = c0v + sreg[q] * wv[q];
                c0v = __builtin_amdgcn_mfma_f32_16x16x32_bf16(glf[q][0], sbs[0], c0v, 0, 0, 0); sn[q] = __builtin_amdgcn_mfma_f32_16x16x32_bf16(glf[q][1], sbs[1], c0v, 0, 0, 0);
                *(LAS f32x4*)(Yf + (s0 + fr) * 68 + f0 + 4 * fq) = y; }
        }
        __syncthreads();
#pragma unroll
        for (int q = 0; q < 2; ++q) { sreg[q] = sn[q]; st_tile(Sb, fbase + q * 16, s0, sn[q], fr, fq); }
        if (c + 1 < 32) {
            LAS bf16* Gn = Mx + (1 + 4 * (p ^ 1)) * MSZ;
            *(LAS u32x4*)(Gn + MO(tt, jc * 8)) = T4[u].g; *(LAS u32x4*)(Gn + MSZ + MO(tt, jc * 8)) = T4[u].h; *(LAS u32x4*)(Gn + 2 * MSZ + MO(tt, jc * 8)) = T4[u].r; *(LAS u32x4*)(Gn + 3 * MSZ + MO(tt, jc * 8)) = T4[u].y;
            if (tid < 64) Wl[(p ^ 1) * 64 + tid] = T4[u].wl;
            if (c + 3 < 32) CH_LOADT(T4[u], c + 3);
        }
        {
            const u32x4 v4 = Q4[u].v, gg4 = Q4[u].gg; const float bon = Q4[u].bon;
            float y[8], s1 = 0.f;
            const f32x4 ya = *(const LAS f32x4*)(Yf + tt * 68 + jc * 8), yb = *(const LAS f32x4*)(Yf + tt * 68 + jc * 8 + 4);
#pragma unroll
            for (int j = 0; j < 4; ++j) { y[j] = ya[j]; y[4 + j] = yb[j]; }
#pragma unroll
            for (int j = 0; j < 8; ++j) s1 += y[j];
            const float mean = red8(s1) * (1.0f / 64.0f); float s2 = 0.f;
#pragma unroll
            for (int j = 0; j < 8; ++j) { y[j] -= mean; s2 += y[j] * y[j]; }
            const float rstd = __builtin_amdgcn_rsqf(red8(s2) * (1.0f / 64.0f) + GN_EPS);
            const unsigned vw[4] = {v4.x, v4.y, v4.z, v4.w}, gw_[4] = {gg4.x, gg4.y, gg4.z, gg4.w};
            float o[8];
#pragma unroll
            for (int j = 0; j < 4; ++j) { o[2 * j] = (y[2 * j] * rstd * lnw[2 * j] + lnb[2 * j] + bon * bf_lo(vw[j])) * bf_lo(gw_[j]); o[2 * j + 1] = (y[2 * j + 1] * rstd * lnw[2 * j + 1] + lnb[2 * j + 1] + bon * bf_hi(vw[j])) * bf_hi(gw_[j]); }
            u32x4 w; w.x = pk2(o[0], o[1]); w.y = pk2(o[2], o[3]); w.z = pk2(o[4], o[5]); w.w = pk2(o[6], o[7]);
            st16_wt(YC + (row0 + c * 64 + tt) * D + ch0, w);
        }
        if (c + 2 < 32) CH_LOADQ(Q4[u], c + 2);
      }
    }
#undef CH_LOADT
#undef CH_LOADQ
    __syncthreads();
}

__device__ __forceinline__ void attn_phase(ArgsP a, int L, int rep, LAS unsigned char* lds, int tid, int wave, int lane) {
    unsigned char* ws = a->ws;
    const bf16* Za = (const bf16*)(ws + WS_ZA); bf16* YC = (bf16*)(ws + WS_YC);
    unsigned* ctl = (unsigned*)(ws + WS_CTL);
    volatile LAS int* qs = (volatile LAS int*)(lds + LDSCTL_OFF + LC_Q);
    constexpr int TILE_B = 65536;
    LAS float* Bt = (LAS float*)(lds + 2 * TILE_B);
    const int hl = wave >> 1, qh = wave & 1, fr = lane & 15, fq = lane >> 4;
    constexpr float LOG2E = 1.4426950408889634f;
    const int myq = (int)(xb_xcc_id() & 7u);
    __syncthreads();
    for (int i = tid; i < 5120; i += 512) { const int hh = i / 640, x = i - hh * 640; int rel = 575 - x; rel = rel > 256 ? 256 : rel; rel = rel < -63 ? -63 : rel; Bt[i] = a->in[I_RELB][((size_t)L * 8 + hh) * 320 + rel + 63] * LOG2E; }
    const unsigned lds0 = (unsigned)(uintptr_t)lds;
    const unsigned wdst = (unsigned)((wave >> 2) * 32768 + (wave & 3) * 8192);
    const size_t dlane = (size_t)(lane >> 3) * NA + (wave < 4 ? 512 : 1024) + (wave & 3) * 64 + (((lane & 7) ^ (lane >> 3)) * 8);
#define ATT_DMA(bufsel_, src_) do { _Pragma("unroll") for (int _i = 0; _i < 8; ++_i) { unsigned keep_; const unsigned dst_ = (unsigned)__builtin_amdgcn_readfirstlane((int)(lds0 + (unsigned)((bufsel_) * TILE_B) + wdst + (unsigned)(_i * 1024))); \
        asm volatile("s_mov_b32 %0, m0\n\ts_mov_b32 m0, %2\n\ts_nop 0\n\tglobal_load_lds_dwordx4 %1, off\n\ts_mov_b32 m0, %0" : "=&s"(keep_) : "v"((src_) + (size_t)_i * 8 * NA), "s"(dst_) : "memory"); } } while (0)
#define ATT_QADDR(qi_) (ctl + CW_QUEUE + ((L * 2 + rep) * 8 + ((myq + (qi_)) & 7)) * 64)
#define ATT_ITEM(qi_, j_) ((((((myq + (qi_)) & 7) * 4 + ((j_) & 3)) >> 1) * 64) + (31 - ((j_) >> 2)) * 2 + (((((myq + (qi_)) & 7) * 4 + ((j_) & 3))) & 1))
#define ATT_SRC0(item_) (Za + ((size_t)((item_) >> 6) * SEQ + (size_t)((((item_) >> 1) & 31) - 8 + (((((item_) >> 1) & 31) < 8) ? 8 - (((item_) >> 1) & 31) : 0)) * 64) * NA + ((item_) & 1) * 256 + dlane)
#define ATT_LOADQ(dst_, item_) do { const size_t tq_ = (size_t)((item_) >> 6) * SEQ + (((item_) >> 1) & 31) * 64 + qh * 32 + fr; _Pragma("unroll") for (int m = 0; m < 2; ++m) _Pragma("unroll") for (int ks = 0; ks < 2; ++ks) \
        dst_[m][ks] = *(const bf16x8*)(Za + (tq_ + m * 16) * NA + (4 * ((item_) & 1) + hl) * 64 + ks * 32 + fq * 8); } while (0)
    int qi = 0, cur = -1;
#define ATT_SYNC_POP(dst_) do { dst_ = -1; while (qi < 8) { __syncthreads(); if (tid == 0) qs[0] = (int)atomicAdd(ATT_QADDR(qi), 1u); __syncthreads(); const int j_ = qs[0]; if (j_ >= 128) { ++qi; continue; } dst_ = ATT_ITEM(qi, j_); break; } } while (0)
    ATT_SYNC_POP(cur);
    bool pre = false; int pb = 0;
    bf16x8 qf[2][2];
    const int x7 = fr & 7;
    const int vr7 = (fq & 1) * 4 + (fr >> 2);
    while (cur >= 0) {
        const int b = cur >> 6, c = (cur >> 1) & 31, hq = cur & 1, head = 4 * hq + hl;
        const int jb0 = (c < 8 ? 8 - c : 0);
        const bf16* dsrc = ATT_SRC0(cur);
        if (!pre) { ATT_DMA(pb, dsrc); ATT_LOADQ(qf, cur); }
        unsigned jn = 0u;
        if (jb0 == 8) { if (tid == 0) jn = atomicAdd(ATT_QADDR(qi), 1u); }
#pragma unroll
        for (int m = 0; m < 2; ++m)
#pragma unroll
            for (int ks = 0; ks < 2; ++ks) asm volatile("" :: "v"(qf[m][ks]));
        const size_t tq0 = (size_t)b * SEQ + c * 64 + qh * 32 + fr;
        f32x4 oacc[2][4];
#pragma unroll
        for (int m = 0; m < 2; ++m)
#pragma unroll
            for (int d = 0; d < 4; ++d) oacc[m][d] = (f32x4){0.f, 0.f, 0.f, 0.f};
        float mrun[2] = {-1e30f, -1e30f}, lrun[2] = {0.f, 0.f};
        const LAS float* bh = Bt + (hq * 4 + hl) * 640;
        int nxt = -1; bf16x8 qfn[2][2];
#pragma unroll
        for (int m = 0; m < 2; ++m)
#pragma unroll
            for (int ks = 0; ks < 2; ++ks) qfn[m][ks] = qf[m][ks];
        for (int jb = jb0; jb <= 8; ++jb, pb ^= 1) {
            if (jb == 8 && tid == 0) qs[0] = (int)jn;
            asm volatile("s_waitcnt vmcnt(0) lgkmcnt(0)" ::: "memory");
            __builtin_amdgcn_s_barrier(); asm volatile("" ::: "memory");
            if (jb < 8) { dsrc += (size_t)64 * NA; ATT_DMA(pb ^ 1, dsrc);
                if (jb == jb0) { if (tid == 0) jn = atomicAdd(ATT_QADDR(qi), 1u); } }
            else { const int j_ = qs[0];
                if (j_ < 128) { nxt = ATT_ITEM(qi, j_); const bf16* nsrc = ATT_SRC0(nxt); ATT_DMA(pb ^ 1, nsrc); ATT_LOADQ(qfn, nxt); } else nxt = -2; }
            const LAS bf16* Kh = (const LAS bf16*)(lds + pb * TILE_B) + hl * 4096; const LAS bf16* Vh = Kh + 16384;
            f32x4 sacc[2][4];
#pragma unroll
            for (int kt = 0; kt < 4; ++kt) {
                const LAS bf16* kp = Kh + (kt * 16 + fr) * 64;
                const bf16x8 kf0 = *(const LAS bf16x8*)(kp + ((fq ^ x7) * 8)), kf1 = *(const LAS bf16x8*)(kp + (((4 + fq) ^ x7) * 8));
#pragma unroll
                for (int m = 0; m < 2; ++m) { f32x4 z = (f32x4){0.f, 0.f, 0.f, 0.f}; z = __builtin_amdgcn_mfma_f32_16x16x32_bf16(kf0, qf[m][0], z, 0, 0, 0); sacc[m][kt] = __builtin_amdgcn_mfma_f32_16x16x32_bf16(kf1, qf[m][1], z, 0, 0, 0); } }
            const float bconst = bh[0];
            f32x4 bb[5];
            if (jb > 3) { const LAS float* bp0 = bh + (63 - (qh * 32 + fr)) + jb * 64 + fq * 4 - 16;
#pragma unroll
                for (int g = 0; g < 5; ++g) bb[g] = (f32x4){bp0[g * 16], bp0[g * 16 + 1], bp0[g * 16 + 2], bp0[g * 16 + 3]}; }
            else {
#pragma unroll
                for (int g = 0; g < 5; ++g) bb[g] = (f32x4){bconst, bconst, bconst, bconst}; }
#pragma unroll
            for (int m = 0; m < 2; ++m) {
                float tmax = -1e30f;
#pragma unroll
                for (int kt = 0; kt < 4; ++kt) { const f32x4 sv = sacc[m][kt] * (0.125f * LOG2E) + bb[kt + 1 - m]; sacc[m][kt] = sv; tmax = fmaxf(fmaxf(tmax, fmaxf(sv[0], sv[1])), fmaxf(sv[2], sv[3])); }
                tmax = rows32_max(rows16_max(tmax));
                const float mnew = fmaxf(mrun[m], tmax), alpha = __builtin_amdgcn_exp2f(mrun[m] - mnew); mrun[m] = mnew;
                float psum = 0.f;
#pragma unroll
                for (int kt = 0; kt < 4; ++kt)
#pragma unroll
                    for (int j = 0; j < 4; ++j) { const float p = __builtin_amdgcn_exp2f(sacc[m][kt][j] - mnew); sacc[m][kt][j] = p; psum += p; }
                lrun[m] = lrun[m] * alpha + psum;
#pragma unroll
                for (int d = 0; d < 4; ++d) oacc[m][d] = oacc[m][d] * alpha;
            }
#pragma unroll
            for (int s2 = 0; s2 < 2; ++s2) {
                bf16x8 pf[2];
#pragma unroll
                for (int m = 0; m < 2; ++m) { u32x4 pw; pw.x = pg8::cvt_pk_bf16(sacc[m][2 * s2][0], sacc[m][2 * s2][1]); pw.y = pg8::cvt_pk_bf16(sacc[m][2 * s2][2], sacc[m][2 * s2][3]); pw.z = pg8::cvt_pk_bf16(sacc[m][2 * s2 + 1][0], sacc[m][2 * s2 + 1][1]); pw.w = pg8::cvt_pk_bf16(sacc[m][2 * s2 + 1][2], sacc[m][2 * s2 + 1][3]);
                    pf[m] = __builtin_bit_cast(bf16x8, pw); }
                const LAS bf16* vp = Vh + (s2 * 32 + fq * 4 + (fr >> 2)) * 64 + 4 * (fr & 1);
#pragma unroll
                for (int d = 0; d < 4; ++d) {
                    const int vc = ((d * 2 + ((fr & 3) >> 1)) ^ vr7) * 8;
                    const u32x2 v0 = __builtin_bit_cast(u32x2, vtr(vp + vc));
                    const u32x2 v1 = __builtin_bit_cast(u32x2, vtr(vp + 16 * 64 + vc));
                    const bf16x8 vf = __builtin_bit_cast(bf16x8, (u32x4){v0.x, v0.y, v1.x, v1.y});
#pragma unroll
                    for (int m = 0; m < 2; ++m) oacc[m][d] = __builtin_amdgcn_mfma_f32_16x16x32_bf16(vf, pf[m], oacc[m][d], 0, 0, 0);
                }
            }
        }
#pragma unroll
        for (int m = 0; m < 2; ++m) {
            float l = rows32_sum(rows16_sum(lrun[m]));
            const float inv = 1.0f / l;
#pragma unroll
            for (int d = 0; d < 4; ++d) { u32x2 o; o.x = pk2(oacc[m][d][0] * inv, oacc[m][d][1] * inv); o.y = pk2(oacc[m][d][2] * inv, oacc[m][d][3] * inv);
                *(u32x2*)(YC + (tq0 + m * 16) * D + 512 + head * 64 + d * 16 + fq * 4) = o; }
        }
        if (nxt == -2) { ++qi; ATT_SYNC_POP(nxt); pre = false; }
        else { pre = true;
#pragma unroll
            for (int m = 0; m < 2; ++m)
#pragma unroll
                for (int ks = 0; ks < 2; ++ks) qf[m][ks] = qfn[m][ks]; }
        cur = nxt;
    }
    asm volatile("s_waitcnt vmcnt(0)" ::: "memory");
    __syncthreads();
#undef ATT_DMA
#undef ATT_QADDR
#undef ATT_ITEM
#undef ATT_SRC0
#undef ATT_LOADQ
#undef ATT_SYNC_POP
}

__device__ __forceinline__ void phase_router(ArgsP a, int L, LAS unsigned char* lds, int gw, int NGW, int wave, int lane, int rep) {
    unsigned char* ws = a->ws;
    const bf16* h = H_CUR(a, L); float* RSTD = (float*)(ws + WS_RSTD);
    const bf16* WRH = (const bf16*)(ws + WS_TAB + TAB_WRH); const bf16* WRL = (const bf16*)(ws + WS_TAB + TAB_WRL);
    int* perm = (int*)(ws + WS_PERM); float* srs = (float*)(ws + WS_SRS); float* scw = (float*)(ws + WS_SCW); int* tokslot = (int*)(ws + WS_TOKSLOT);
    unsigned* cnt = (unsigned*)(ws + WS_CTL) + CW_CNT + (L * 2 + rep) * 2048;
    LAS float* lg = (LAS float*)(lds + wave * 4096);
    LAS float* lbias = (LAS float*)(lds + 32768);
    LAS unsigned* lcnt = (LAS unsigned*)(lds + 32768 + 256); LAS unsigned* lbase = lcnt + 32;
    constexpr int SBK = 264; LAS bf16* Bs = (LAS bf16*)(lds + 40960);
    const int fr = lane & 15, fq = lane >> 4, tid = wave * 64 + lane;
    if (tid < 4) lbias[tid] = a->in[I_RGB][L * 4 + tid]; else if (tid < 36) lbias[tid] = a->in[I_REB][L * 32 + tid - 4];
    const int ntrip = (T / 16 + NGW - 1) / NGW;
    for (int trip = 0; trip < ntrip; ++trip) {
        const int rt = trip * NGW + gw; const bool live = rt < T / 16;
        if (tid < 32) lcnt[tid] = 0u;
        __syncthreads();
        int e1 = 0, e2 = 0; unsigned lp1 = 0u, lp2 = 0u; float rstd = 0.f, c1 = 0.f, c2 = 0.f; const int row = rt * 16 + fr;
        f32x4 acc[3]; acc[0] = acc[1] = acc[2] = (f32x4){0.f, 0.f, 0.f, 0.f};
        float ssq = 0.f;
        {
            const bf16* hr = h + (size_t)(live ? row : 0) * D + 8 * fq;
            u32x4 breg[6];
#define RT_LOADB(kc_) do { _Pragma("unroll") for (int i = 0; i < 6; ++i) { const int idx = tid + 512 * i, arr = idx / 1536, rem = idx - arr * 1536, r_ = rem >> 5, c_ = rem & 31; \
                breg[i] = *(const u32x4*)((arr ? WRL : WRH) + (size_t)r_ * D + (kc_) * 256 + c_ * 8); } } while (0)
            RT_LOADB(0);
#pragma unroll 1
            for (int kc = 0; kc < 4; ++kc) {
                __syncthreads();
#pragma unroll
                for (int i = 0; i < 6; ++i) { const int idx = tid + 512 * i, arr = idx / 1536, rem = idx - arr * 1536, r_ = rem >> 5, c_ = rem & 31; *(LAS u32x4*)(Bs + (arr * 48 + r_) * SBK + c_ * 8) = breg[i]; }
                __syncthreads();
                if (kc < 3) RT_LOADB(kc + 1);
#pragma unroll
                for (int ks = 0; ks < 8; ++ks) {
                    const u32x4 hv = *(const u32x4*)(hr + kc * 256 + 32 * ks); const unsigned hw[4] = {hv.x, hv.y, hv.z, hv.w};
#pragma unroll
                    for (int j = 0; j < 4; ++j) { const float p = bf_lo(hw[j]), q = bf_hi(hw[j]); ssq += p * p + q * q; }
                    const bf16x8 ah = __builtin_bit_cast(bf16x8, hv);
#pragma unroll
                    for (int nt = 0; nt < 3; ++nt) { const LAS bf16* bp_ = Bs + (nt * 16 + fr) * SBK + 32 * ks + 8 * fq; const bf16x8 bh = *(const LAS bf16x8*)bp_, bl = *(const LAS bf16x8*)(bp_ + 48 * SBK);
                        acc[nt] = __builtin_amdgcn_mfma_f32_16x16x32_bf16(bh, ah, acc[nt], 0, 0, 0); acc[nt] = __builtin_amdgcn_mfma_f32_16x16x32_bf16(bl, ah, acc[nt], 0, 0, 0); }
                }
            }
#undef RT_LOADB
        }
        if (live) {
        ssq = rows32_sum(rows16_sum(ssq));
        rstd = 1.0f / sqrtf(ssq * (1.0f / D) + RMS_EPS);
        if (fq == 0) RSTD[row] = rstd;
#pragma unroll
        for (int nt = 0; nt < 3; ++nt) *(LAS f32x4*)(lg + fr * 52 + nt * 16 + 4 * fq) = acc[nt];
        asm volatile("s_waitcnt lgkmcnt(0)" ::: "memory");
        if (fq == 0) {
            const LAS float* lr = lg + fr * 52;
            float gl[4]; float gmax = -1e30f; int gsel = 0;
#pragma unroll
            for (int j = 0; j < 4; ++j) { gl[j] = lr[j] * rstd + lbias[j]; if (gl[j] > gmax) { gmax = gl[j]; gsel = j; } }
            float gs = 0.f;
#pragma unroll
            for (int j = 0; j < 4; ++j) gs += __expf(gl[j] - gmax);
            const float pg = 1.0f / gs;
            float l1 = -1e30f, l2 = -1e30f; int i1 = 0, i2 = 0;
#pragma unroll
            for (int j = 0; j < 8; ++j) { const float v = lr[4 + gsel * 8 + j] * rstd + lbias[4 + gsel * 8 + j];
                const bool gt1 = v > l1, gt2 = v > l2;
                l2 = gt1 ? l1 : (gt2 ? v : l2); i2 = gt1 ? i1 : (gt2 ? j : i2); l1 = gt1 ? v : l1; i1 = gt1 ? j : i1; }
            const float w1 = 1.0f / (1.0f + __expf(l2 - l1));
            e1 = gsel * 8 + i1; e2 = gsel * 8 + i2; c1 = pg * w1; c2 = pg * (1.0f - w1);
            lp1 = atomicAdd((unsigned*)(lcnt + e1), 1u); lp2 = atomicAdd((unsigned*)(lcnt + e2), 1u);
        }
        }
        __syncthreads();
        if (tid < 32) { const unsigned n = lcnt[tid]; lbase[tid] = n ? atomicAdd(cnt + tid * 64, n) : 0u; }
        __syncthreads();
        if (live && fq == 0) {
            const size_t s1 = (size_t)e1 * T + lbase[e1] + lp1, s2 = (size_t)e2 * T + lbase[e2] + lp2;
            perm[s1] = row; srs[s1] = rstd; scw[s1] = c1; perm[s2] = row; srs[s2] = rstd; scw[s2] = c2;
            tokslot[row * 2] = (int)s1; tokslot[row * 2 + 1] = (int)s2;
        }
        __syncthreads();
    }
}

__device__ __forceinline__ void moe_tables(LAS unsigned char* lds, const unsigned* cnt, int tid) {
    volatile LAS int* prefix = (volatile LAS int*)(lds + LDSCTL_OFF + LC_PREFIX); volatile LAS int* ebase = (volatile LAS int*)(lds + LDSCTL_OFF + LC_EBASE); volatile LAS int* lc = (volatile LAS int*)(lds + LDSCTL_OFF + LC_CNT);
    __syncthreads();
    if (tid < 64) {
        const int c = (tid < NEXP) ? (int)__hip_atomic_load(cnt + (tid & 31) * 64, __ATOMIC_RELAXED, __HIP_MEMORY_SCOPE_AGENT) : 0;
        const int t = (c + 255) >> 8; int incl = t;
#pragma unroll
        for (int o = 1; o < 32; o <<= 1) { const int v = __shfl_up(incl, o); if ((tid & 63) >= o) incl += v; }
        if (tid < NEXP) { lc[tid] = c; prefix[tid] = incl - t; ebase[tid] = (incl - t) * 256; }
        if (tid == NEXP - 1) { prefix[NEXP] = incl; ebase[NEXP] = incl * 256; }
    }
    __syncthreads();
}

__device__ __forceinline__ unsigned char* ws_ptr(ArgsP ap) { unsigned char* w = ap->ws; asm volatile("" : "+s"(w)); return w; }

#define LANEVARS int tid = threadIdx.x; asm volatile("" : "+v"(tid)); const int lane = tid & 63, wave = __builtin_amdgcn_readfirstlane(tid >> 6); const int gw = blockIdx.x * 8 + wave; const int G = gridDim.x, NGW = G * 8; (void)lane; (void)gw; (void)G; (void)NGW
#if MK_ONE_LAUNCH
#define GRID_BAR() do { XcdBarrier bar_; bar_.bar = (unsigned*)(ws_ptr(args_ptr()) + WS_CTL) + CW_BAR; bar_.x = xb_xcc_id(); bar_.st = (volatile LAS unsigned*)(lds + LDSCTL_OFF + LC_XB); xcd_barrier(bar_); } while (0)
#define PH_RANGE(k) true
#else
#define GRID_BAR() do { } while (0)
#define PH_RANGE(k) (args_ptr()->ph_lo <= (k) && (k) < args_ptr()->ph_hi)
#endif
#ifdef ONLY_PHASE
#define PH_EN(k) ((((k) % 11) == ONLY_PHASE && (k) < 22) || ((k) == 22 && ONLY_PHASE == 22))
#else
#define PH_EN(k) true
#endif
#define IN(k) (PH_EN(k) && PH_RANGE(k))
#define SEAM(k) do { if (IN(k) && IN((k) + 1)) GRID_BAR(); } while (0)
#ifdef REP_PHASE
#define NREP(k) (((k) % 11) == REP_PHASE && (k) < 22 ? 2 : 1)
#else
#define NREP(k) 1
#endif

template <int L> __device__ __forceinline__ void layer_phases(LAS unsigned char* lds) {
        const int pb = L * 11;
        for (int rep = 0; rep < NREP(pb + 0); ++rep) if (IN(pb + 0)) { if (rep) GRID_BAR(); LANEVARS; ArgsP ap = args_ptr(); phase_convert(ap, L, lds, gw, NGW, wave, lane, ap->in[I_X], (L == 1 && MK_ONE_LAUNCH) ? CONV_EARLY : 0, CONV_SPLIT, true); }
        SEAM(pb + 0);
        for (int rep = 0; rep < NREP(pb + 1); ++rep) if (IN(pb + 1)) { if (rep) GRID_BAR(); LANEVARS;
            unsigned char* ws = ws_ptr(args_ptr());
            pg8::PlainA P{(const char*)H_CUR(args_ptr(), L), D * 2, nullptr}; pg8::StaticOrder S; S.init(T, NIN, G, (int)blockIdx.x);
            pg8::EpiZ E{(bf16*)(ws + WS_ZR), (bf16*)(ws + WS_ZA), (const float*)(ws + WS_RSTD)};
            pg8::gemm_phase<pg8::PlainA, pg8::EpiZ, pg8::StaticOrder, true>(lds, P, (const char*)(ws + WS_W + W_IN), D, 0, S, E);
            {
                const int rounds = (S.nwg + G - 1) / G, nfull = S.nwg - (rounds - 1) * G; int ng = G, cr = (int)blockIdx.x;
                if (nfull < G && (G - nfull) * 4 >= G) { ng = G - nfull; cr = (int)blockIdx.x - nfull; }
                if (cr >= 0) { __syncthreads(); ArgsP ap = args_ptr(); phase_convert(ap, L, lds, cr * 8 + wave, ng * 8, wave, lane, nullptr, (L == 1 && MK_ONE_LAUNCH && CONV_EARLY > CONV_SPLIT) ? CONV_EARLY : CONV_SPLIT, 1 << 30, false); }
            }
        }
        SEAM(pb + 1);
        for (int rep = 0; rep < NREP(pb + 3); ++rep) if (IN(pb + 3)) { if (rep) GRID_BAR(); LANEVARS;
            ArgsP ap = args_ptr();
            HeadPF pf; if ((int)blockIdx.x < NBATCH * 32) head_prefetch(ap, L, (int)blockIdx.x * 8, tid, wave, pf);
            for (int bc = blockIdx.x; bc < NBATCH * 32; bc += G) { local_tile_stage(ap, L, bc, lds, tid, wave, lane);
#pragma unroll 1
                for (int hh = 0; hh < 8; ++hh) { const int nu = (hh < 7) ? bc * 8 + hh + 1 : ((bc + G < NBATCH * 32) ? (bc + G) * 8 : -1); local_head(ap, L, bc * 8 + hh, nu, pf, lds, tid, wave, lane); } }
        }
        SEAM(pb + 3);
        for (int rep = 0; rep < NREP(pb + 4); ++rep) if (IN(pb + 4)) { if (rep) GRID_BAR(); LANEVARS;
            ArgsP ap = args_ptr();
#ifdef REP_SUB
            if (rep == 0 || REP_SUB == 1)
#endif
            for (int s = blockIdx.x; s < NBATCH * 8; s += G) chain_sequence(ap, L, s, lds, tid, wave, lane);
#ifdef REP_SUB
            if (rep == 0 || REP_SUB == 2)
#endif
            attn_phase(ap, L, rep, lds, tid, wave, lane);
        }
        SEAM(pb + 4);
        if (IN(pb + 5)) { LANEVARS;
            ArgsP ap = args_ptr(); unsigned char* ws = ws_ptr(ap);
            { const float* p = ap->in[I_P] + (size_t)L * T * 256; bf16* PB = (bf16*)(ws + WS_PB);
              const size_t npc = (size_t)T * 256 / 8;
              for (size_t c0 = (size_t)gw * 256 + lane; c0 < npc; c0 += (size_t)NGW * 256) { f32x4 x0[4], x1[4];
#pragma unroll
                  for (int q = 0; q < 4; ++q) { const size_t cc = c0 + q * 64; x0[q] = *(const f32x4*)(p + cc * 8); x1[q] = *(const f32x4*)(p + cc * 8 + 4); }
#pragma unroll
                  for (int q = 0; q < 4; ++q) { const size_t cc = c0 + q * 64; u32x4 w; w.x = pk2(x0[q][0], x0[q][1]); w.y = pk2(x0[q][2], x0[q][3]); w.z = pk2(x1[q][0], x1[q][1]); w.w = pk2(x1[q][2], x1[q][3]); st16_wt(PB + cc * 8, w); } } }
            pg8::PlainA P{(const char*)(ws + WS_YC), D * 2, nullptr}; pg8::StaticOrder S; S.init(T, D, G, (int)blockIdx.x);
            pg8::EpiRes E{H_CUR(ap, L)};
            pg8::gemm_phase<pg8::PlainA, pg8::EpiRes, pg8::StaticOrder, true>(lds, P, (const char*)(ws + WS_W + W_OUT), D, 0, S, E);
        }
        SEAM(pb + 5);
        for (int rep = 0; rep < NREP(pb + 6); ++rep) if (IN(pb + 6)) { if (rep) GRID_BAR(); LANEVARS;
#ifdef REP_SUB
            if (rep == 0 || REP_SUB == 1)
#endif
            phase_router(args_ptr(), L, lds, gw, NGW, wave, lane, rep);
        }
        SEAM(pb + 6);
        for (int rep = 0; rep < NREP(pb + 7); ++rep) if (IN(pb + 7)) { if (rep) GRID_BAR(); LANEVARS;
            unsigned char* ws = ws_ptr(args_ptr());
            moe_tables(lds, (unsigned*)(ws + WS_CTL) + CW_CNT + L * 4096, tid);
            volatile LAS int* prefix = (volatile LAS int*)(lds + LDSCTL_OFF + LC_PREFIX); volatile LAS int* ebase = (volatile LAS int*)(lds + LDSCTL_OFF + LC_EBASE); volatile LAS int* lc = (volatile LAS int*)(lds + LDSCTL_OFF + LC_CNT);
            pg8::GatherA P{(const char*)H_CUR(args_ptr(), L), D * 2, (const int*)(ws + WS_PERM), lc, (volatile LAS unsigned*)(lds + LDSCTL_OFF + LC_ROT)}; pg8::MoeOrder S{prefix, ebase, 2, G, (int)blockIdx.x};
            pg8::EpiHid E{(bf16*)(ws + WS_HID), (const float*)(ws + WS_SRS), (const float*)(ws + WS_SCW), lc};
            pg8::gemm_phase<pg8::GatherA, pg8::EpiHid, pg8::MoeOrder, true>(lds, P, (const char*)(ws + WS_W + W_13), D, 512, S, E);
            {
                const int total = prefix[NEXP] * 2, rounds = (total + G - 1) / G, nfull = total - (rounds - 1) * G;
                int ng = G, cr = (int)blockIdx.x;
                if (nfull < G && (G - nfull) * 8 >= G) { ng = G - nfull; cr = (int)blockIdx.x - nfull; }
                if (cr >= 0) { __syncthreads();
                    pg8::PlainA P2{(const char*)(ws + WS_PB), 256 * 2, nullptr}; pg8::StaticOrder S2; S2.init(T, D, ng, cr);
                    pg8::EpiB E2{(bf16*)(ws + WS_PP), D};
                    pg8::gemm_phase<pg8::PlainA, pg8::EpiB, pg8::StaticOrder, true>(lds, P2, (const char*)(ws + WS_W + W_PP), 256, 0, S2, E2); }
            }
        }
        SEAM(pb + 7);
        for (int rep = 0; rep < NREP(pb + 8); ++rep) if (IN(pb + 8)) { if (rep) GRID_BAR(); LANEVARS;
            unsigned char* ws = ws_ptr(args_ptr());
#if !MK_ONE_LAUNCH || defined(ONLY_PHASE)
            moe_tables(lds, (unsigned*)(ws + WS_CTL) + CW_CNT + L * 4096, tid);
#endif
            volatile LAS int* prefix = (volatile LAS int*)(lds + LDSCTL_OFF + LC_PREFIX); volatile LAS int* ebase = (volatile LAS int*)(lds + LDSCTL_OFF + LC_EBASE);
            pg8::PlainA P{(const char*)(ws + WS_HID), 256 * 2, nullptr}; pg8::MoeOrder S{prefix, ebase, 4, G, (int)blockIdx.x};
            pg8::EpiB E{(bf16*)(ws + WS_Y2), D};
            pg8::gemm_phase<pg8::PlainA, pg8::EpiB, pg8::MoeOrder, true>(lds, P, (const char*)(ws + WS_W + W_2), 256, D, S, E);
#if MK_ONE_LAUNCH
            if (L == 0) {
                const int total = prefix[NEXP] * 4, rounds = (total + G - 1) / G, nfull = total - (rounds - 1) * G; int ng = G, cr = (int)blockIdx.x;
                if (nfull < G && (G - nfull) * 4 >= G) { ng = G - nfull; cr = (int)blockIdx.x - nfull; }
                if (cr >= 0) { __syncthreads(); phase_convert(args_ptr(), 1, lds, cr * 8 + wave, ng * 8, wave, lane, nullptr, 0, CONV_EARLY, false); }
            }
#endif
        }
        SEAM(pb + 8);
        if (IN(pb + 9)) { LANEVARS;
            ArgsP ap = args_ptr(); unsigned char* ws = ws_ptr(ap); bf16* h = H_CUR(ap, L);
#if !MK_ONE_LAUNCH || defined(ONLY_PHASE)
            moe_tables(lds, (unsigned*)(ws + WS_CTL) + CW_CNT + L * 4096, tid);
#endif
            volatile LAS int* ebase = (volatile LAS int*)(lds + LDSCTL_OFF + LC_EBASE);
            const int* tokslot = (const int*)(ws + WS_TOKSLOT); const bf16* Y2 = (const bf16*)(ws + WS_Y2); float* RSTD = (float*)(ws + WS_RSTD);
#define P9_ROW(hv_, pv_, qv_, hr_, m_) do { float sq = 0.f; _Pragma("unroll") for (int j = 0; j < 2; ++j) { const unsigned hw[4] = {hv_[j].x, hv_[j].y, hv_[j].z, hv_[j].w}, pw[4] = {pv_[j].x, pv_[j].y, pv_[j].z, pv_[j].w}, qw[4] = {qv_[j].x, qv_[j].y, qv_[j].z, qv_[j].w}; unsigned ow[4]; \
                    _Pragma("unroll") for (int e = 0; e < 4; ++e) { const float x0 = bf_lo(hw[e]) + bf_lo(pw[e]) + bf_lo(qw[e]), x1 = bf_hi(hw[e]) + bf_hi(pw[e]) + bf_hi(qw[e]); \
                        const unsigned b0 = f2bf(x0), b1 = f2bf(x1); ow[e] = b0 | (b1 << 16); const float y0 = __builtin_bit_cast(float, b0 << 16), y1f = __builtin_bit_cast(float, b1 << 16); sq += y0 * y0 + y1f * y1f; } \
                    st16_wt(hr_ + 64 * j, (u32x4){ow[0], ow[1], ow[2], ow[3]}); } \
                sq = wave_sum(sq); if (lane == 0) RSTD[m_] = 1.0f / sqrtf(sq * (1.0f / D) + RMS_EPS); } while (0)
            int ma = gw, mb = gw + NGW;
            int sa1 = 0, sa2 = 0, sb1 = 0, sb2 = 0;
            if (ma < T) { const int cb = mb < T ? mb : ma; sa1 = tokslot[ma * 2]; sa2 = tokslot[ma * 2 + 1]; sb1 = tokslot[cb * 2]; sb2 = tokslot[cb * 2 + 1]; }
            for (; ma < T; ma += 2 * NGW, mb += 2 * NGW) {
                const bool okb = mb < T; const int cb = okb ? mb : ma;
                const size_t ra1 = (size_t)ebase[sa1 >> 15] + (sa1 & (T - 1)), ra2 = (size_t)ebase[sa2 >> 15] + (sa2 & (T - 1)), rb1 = (size_t)ebase[sb1 >> 15] + (sb1 & (T - 1)), rb2 = (size_t)ebase[sb2 >> 15] + (sb2 & (T - 1));
                u32x4* ha = (u32x4*)(h + (size_t)ma * D) + lane; u32x4* hb = (u32x4*)(h + (size_t)cb * D) + lane;
                const u32x4* pa = (const u32x4*)(Y2 + ra1 * D) + lane; const u32x4* qa = (const u32x4*)(Y2 + ra2 * D) + lane; const u32x4* pbp = (const u32x4*)(Y2 + rb1 * D) + lane; const u32x4* qbp = (const u32x4*)(Y2 + rb2 * D) + lane;
                u32x4 hva[2], pva[2], qva[2], hvb[2], pvb[2], qvb[2];
#pragma unroll
                for (int j = 0; j < 2; ++j) { hva[j] = ha[64 * j]; pva[j] = pa[64 * j]; qva[j] = qa[64 * j]; hvb[j] = hb[64 * j]; pvb[j] = pbp[64 * j]; qvb[j] = qbp[64 * j]; }
                { const int na = ma + 2 * NGW, nb = mb + 2 * NGW; const int ca = na < T ? na : ma, cb2 = nb < T ? nb : ca;
                  sa1 = tokslot[ca * 2]; sa2 = tokslot[ca * 2 + 1]; sb1 = tokslot[cb2 * 2]; sb2 = tokslot[cb2 * 2 + 1]; }
                P9_ROW(hva, pva, qva, ha, ma);
                if (okb) P9_ROW(hvb, pvb, qvb, hb, mb);
            }
#undef P9_ROW
        }
        SEAM(pb + 9);
        for (int rep = 0; rep < NREP(pb + 10); ++rep) if (IN(pb + 10)) { if (rep) GRID_BAR(); LANEVARS;
            ArgsP ap = args_ptr(); unsigned char* ws = ws_ptr(ap);
            pg8::PlainA P{(const char*)H_CUR(ap, L), D * 2, nullptr}; pg8::StaticOrder S; S.init(T, D, G, (int)blockIdx.x);
            pg8::EpiPle E{H_CUR(ap, L), H_NXT(ap, L), (const bf16*)(ws + WS_PP), (const float*)(ws + WS_RSTD), ap->in[I_PGB] + L * D};
            pg8::gemm_phase<pg8::PlainA, pg8::EpiPle, pg8::StaticOrder, true>(lds, P, (const char*)(ws + WS_W + W_PG), D, 0, S, E);
        }
        SEAM(pb + 10);
    }

__global__ void __launch_bounds__(512, 2) fwd_kernel(Args a_unused) {
    extern __shared__ __attribute__((aligned(16))) unsigned char lds_raw[];
    LAS unsigned char* lds = (LAS unsigned char*)lds_raw;
    for (int u = threadIdx.x; u < (LDS_BYTES - LDSCTL_OFF) / 4; u += 512) ((LAS unsigned*)(lds + LDSCTL_OFF))[u] = 0u;
    __syncthreads();
    (void)xcd_barrier_post((unsigned*)(ws_ptr(args_ptr()) + WS_CTL) + CW_BAR, (volatile LAS unsigned*)(lds + LDSCTL_OFF + LC_XB));

    layer_phases<0>(lds);
    layer_phases<1>(lds);
    if (IN(22)) { LANEVARS;
        ArgsP ap = args_ptr(); const bf16* h = H_A(ap); float* out = ap->out;
        const float* fw = ap->in[I_FNW];
        f32x4 wv[2][2];
#pragma unroll
        for (int j = 0; j < 2; ++j) { wv[j][0] = *(const f32x4*)(fw + 8 * lane + 512 * j); wv[j][1] = *(const f32x4*)(fw + 8 * lane + 512 * j + 4); }
        for (int m = gw; m < T; m += 2 * NGW) {
            const int mb = (m + NGW < T) ? m + NGW : m;
            u32x4 wa[2], wb[2];
#pragma unroll
            for (int j = 0; j < 2; ++j) { wa[j] = ((const u32x4*)(h + (size_t)m * D) + lane)[64 * j]; wb[j] = ((const u32x4*)(h + (size_t)mb * D) + lane)[64 * j]; }
#pragma unroll
            for (int r = 0; r < 2; ++r) { const int mr = r ? mb : m; if (r && mb == m) break;
                float x[16]; float sq = 0.f;
#pragma unroll
                for (int j = 0; j < 2; ++j) { const u32x4 w = r ? wb[j] : wa[j]; const unsigned ww[4] = {w.x, w.y, w.z, w.w};
#pragma unroll
                    for (int q = 0; q < 4; ++q) { x[j * 8 + 2 * q] = bf_lo(ww[q]); x[j * 8 + 2 * q + 1] = bf_hi(ww[q]); sq += x[j * 8 + 2 * q] * x[j * 8 + 2 * q] + x[j * 8 + 2 * q + 1] * x[j * 8 + 2 * q + 1]; } }
                sq = wave_sum(sq); const float rstd = 1.0f / sqrtf(sq * (1.0f / D) + RMS_EPS);
#pragma unroll
                for (int j = 0; j < 2; ++j) { const int c0 = 8 * lane + 512 * j; f32x4 o0, o1;
#pragma unroll
                    for (int q = 0; q < 4; ++q) { o0[q] = x[j * 8 + q] * rstd * wv[j][0][q]; o1[q] = x[j * 8 + 4 + q] * rstd * wv[j][1][q]; }
                    *(f32x4*)(out + (size_t)mr * D + c0) = o0; *(f32x4*)(out + (size_t)mr * D + c0 + 4) = o1; }
            }
        }
    }
#undef IN
#undef SEAM
}

extern "C" void kernel_launch(void* const* d_in, const int* in_sizes, int n_in, void* d_out, int out_size, void* d_ws, size_t ws_size, hipStream_t stream) {
    static int grid = 0;
    if (grid == 0) {
        if (n_in != 33 || out_size != T * D || ws_size < WS_END) { fprintf(stderr, "kernel_launch: unexpected shapes (n_in %d out %d ws %zu)\n", n_in, out_size, ws_size); grid = -1; return; }
        int dev = 0, cus = 0;
        if (hipGetDevice(&dev) != hipSuccess || hipDeviceGetAttribute(&cus, hipDeviceAttributeMultiprocessorCount, dev) != hipSuccess) { grid = -1; return; }
        if (hipFuncSetAttribute((const void*)fwd_kernel, hipFuncAttributeMaxDynamicSharedMemorySize, LDS_BYTES) != hipSuccess) { fprintf(stderr, "kernel_launch: hipFuncSetAttribute failed\n"); grid = -1; return; }
        int per_cu = 0;
        if (hipOccupancyMaxActiveBlocksPerMultiprocessor(&per_cu, (const void*)fwd_kernel, 512, LDS_BYTES) != hipSuccess || per_cu < 1) fprintf(stderr, "kernel_launch: occupancy query says %d\n", per_cu);
        (void)hipGetLastError();
        grid = cus;
    }
    if (grid < 0) return;
    hipMemsetAsync((char*)d_ws + WS_CTL, 0, CTL_ZERO_BYTES, stream);
    Args a{};
    for (int i = 0; i < 33; ++i) a.in[i] = (const float*)d_in[i];
    a.out = (float*)d_out; a.ws = (unsigned char*)d_ws;
#if MK_ONE_LAUNCH
    a.ph_lo = 0; a.ph_hi = 23;
    hipLaunchKernelGGL(fwd_kernel, dim3(grid), dim3(512), LDS_BYTES, stream, a);
#else
    for (int ph = 0; ph < 23; ++ph) { a.ph_lo = ph; a.ph_hi = ph + 1; hipLaunchKernelGGL(fwd_kernel, dim3(grid), dim3(512), LDS_BYTES, stream, a); }
#endif
}
```
